# Optimizing an MI355X kernel written in HIP

```python
import math
import jax, jax.numpy as jnp
from jax import lax
import numpy as np

D_MODEL = 1024
BATCH = 8
SEQ = 4096
DEPTH = 2

MEM_LEN = 256
GROUP_WIDTH = D_MODEL // 2
D_MIX = 3 * GROUP_WIDTH
LRU_HEADS = 8
LRU_BLOCK = GROUP_WIDTH // LRU_HEADS
CONV_WIDTH = 4
LRU_C = 8.0
DIFF_HEADS = 4
DIFF_HEAD_DIM = GROUP_WIDTH // DIFF_HEADS
DIFF_QK_DIM = DIFF_HEAD_DIM // 2
MEM_HEADS = 4
MEM_HEAD_DIM = GROUP_WIDTH // MEM_HEADS
Q_BLOCK = 128
N_GROUPS = 4
EXPERTS_PER_GROUP = 8
N_EXPERTS = N_GROUPS * EXPERTS_PER_GROUP
TOP_K = 2
D_EXPERT = 256
EPS = 1e-6

LRU_X_OFF = 0
LRU_G_OFF = LRU_X_OFF + GROUP_WIDTH
DIFF_Q_OFF = LRU_G_OFF + GROUP_WIDTH
DIFF_K_OFF = DIFF_Q_OFF + GROUP_WIDTH
DIFF_V_OFF = DIFF_K_OFF + GROUP_WIDTH
MEM_Q_OFF = DIFF_V_OFF + GROUP_WIDTH
D_IN_PROJ = MEM_Q_OFF + GROUP_WIDTH

kernel_name = 'hymba_rglru_diffattn_hiermoe'


def rms_norm(x, g):
    xf = x.astype(jnp.float32)
    xf = xf * lax.rsqrt(jnp.mean(xf * xf, axis=-1, keepdims=True) + EPS)
    return (xf * g.astype(jnp.float32)).astype(x.dtype)


def _lin_combine(c1, c2):
    a1, b1 = c1
    a2, b2 = c2
    return a1 * a2, a2 * b1 + b2


def rg_lru_group(xb, gb, conv_w, conv_b, wa, ba, wx, bx, lam):
    B, S, C = xb.shape
    xc = lax.conv_general_dilated(xb, conv_w[:, None, :], window_strides=(1,), padding=[(CONV_WIDTH - 1, 0)],
                                  dimension_numbers=('NWC', 'WIO', 'NWC'), feature_group_count=C) + conv_b
    xh = xc.reshape(B, S, LRU_HEADS, LRU_BLOCK)
    r = jax.nn.sigmoid(jnp.einsum('bshi,hij->bshj', xh, wa).reshape(B, S, C) + ba)
    i = jax.nn.sigmoid(jnp.einsum('bshi,hij->bshj', xh, wx).reshape(B, S, C) + bx)
    log_a = (-LRU_C * r.astype(jnp.float32)) * jax.nn.softplus(-lam.astype(jnp.float32))
    a = jnp.exp(log_a)
    b = jnp.sqrt(-jnp.expm1(2.0 * log_a)) * (i * xc).astype(jnp.float32)
    _, h = lax.associative_scan(_lin_combine, (a, b), axis=1)
    return h.astype(xb.dtype) * jax.nn.gelu(gb)


def diff_attention(q, k, v, lam):
    B, S, H, _, d = q.shape
    dv = v.shape[-1]
    nb = S // Q_BLOCK
    qb = jnp.moveaxis(q.reshape(B, nb, Q_BLOCK, H, 2, d), 1, 0)
    key_pos = jnp.arange(S)
    scale = d ** -0.5

    def one_block(args):
        q_blk, blk = args
        s = jnp.einsum('bqhcd,bkhcd->bhcqk', q_blk, k).astype(jnp.float32) * scale
        q_pos = blk * Q_BLOCK + jnp.arange(Q_BLOCK)
        mask = key_pos[None, :] <= q_pos[:, None]
        p = jax.nn.softmax(jnp.where(mask, s, -jnp.inf), axis=-1)
        p = p[:, :, 0] - lam * p[:, :, 1]
        return jnp.einsum('bhqk,bkhv->bqhv', p.astype(v.dtype), v)

    o = lax.map(one_block, (qb, jnp.arange(nb)))
    return jnp.moveaxis(o, 0, 1).reshape(B, S, H, dv)


def memory_attention(q, k, v):
    B, S, H, d = q.shape
    s = jnp.einsum('bshd,bmhd->bhsm', q, k).astype(jnp.float32) * (d ** -0.5)
    p = jax.nn.softmax(s, axis=-1)
    return jnp.einsum('bhsm,bmhd->bshd', p.astype(v.dtype), v).reshape(B, S, H * d)


def hier_moe(xn, w_rg, b_rg, w_re, b_re, w_g, w_u, w_d):
    B, S, D = xn.shape
    xt = xn.reshape(B * S, D)
    pg = jax.nn.softmax((xt @ w_rg + b_rg).astype(jnp.float32), axis=-1)
    g_idx = jnp.argmax(pg, axis=-1)
    g_gate = jnp.max(pg, axis=-1)
    le = (xt @ w_re + b_re).astype(jnp.float32).reshape(-1, N_GROUPS, EXPERTS_PER_GROUP)
    le_sel = jnp.take_along_axis(le, g_idx[:, None, None], axis=1)[:, 0]
    top_w, top_i = lax.top_k(jax.nn.softmax(le_sel, axis=-1), TOP_K)
    top_w = top_w / jnp.sum(top_w, axis=-1, keepdims=True)
    e_w = jnp.sum(jax.nn.one_hot(top_i, EXPERTS_PER_GROUP, dtype=jnp.float32) * top_w[..., None], axis=1)
    combine = (jax.nn.one_hot(g_idx, N_GROUPS, dtype=jnp.float32)[:, :, None]
               * (g_gate[:, None] * e_w)[:, None, :]).astype(xn.dtype)
    wg = w_g.reshape(N_GROUPS, EXPERTS_PER_GROUP, D, D_EXPERT)
    wu = w_u.reshape(N_GROUPS, EXPERTS_PER_GROUP, D, D_EXPERT)
    wd = w_d.reshape(N_GROUPS, EXPERTS_PER_GROUP, D_EXPERT, D)
    out = jnp.zeros_like(xt)
    for g in range(N_GROUPS):
        h = jax.nn.silu(jnp.einsum('td,edf->tef', xt, wg[g])) * jnp.einsum('td,edf->tef', xt, wu[g])
        out = out + jnp.einsum('tef,efd->td', h * combine[:, g, :, None], wd[g])
    return out.reshape(B, S, D)


def setup_inputs(seed: int = 0) -> dict:
    key = jax.random.key(seed)
    ks = jax.random.split(key, 32)
    f32 = jnp.float32
    nrm = lambda k, shape, s: jax.random.normal(k, shape, f32) * s
    gain = lambda k, shape: 1.0 + 0.02 * jax.random.normal(k, shape, f32)
    a_c = jax.random.uniform(ks[10], (DEPTH, GROUP_WIDTH), f32, 0.9, 0.999)
    a_base = a_c ** (1.0 / LRU_C)
    rg_lambda = jnp.log(a_base) - jnp.log1p(-a_base)
    return {
        'x': nrm(ks[0], (BATCH, SEQ, D_MODEL), 1.0),
        'mem': nrm(ks[1], (BATCH, MEM_LEN, D_MODEL), 1.0),
        'norm1_g': gain(ks[2], (DEPTH, D_MODEL)),
        'w_in': nrm(ks[3], (DEPTH, D_MODEL, D_IN_PROJ), D_MODEL ** -0.5),
        'conv_w': nrm(ks[4], (DEPTH, CONV_WIDTH, GROUP_WIDTH), CONV_WIDTH ** -0.5),
        'conv_b': nrm(ks[5], (DEPTH, GROUP_WIDTH), 0.02),
        'rg_wa': nrm(ks[6], (DEPTH, LRU_HEADS, LRU_BLOCK, LRU_BLOCK), LRU_BLOCK ** -0.5),
        'rg_ba': nrm(ks[7], (DEPTH, GROUP_WIDTH), 0.02),
        'rg_wx': nrm(ks[8], (DEPTH, LRU_HEADS, LRU_BLOCK, LRU_BLOCK), LRU_BLOCK ** -0.5),
        'rg_bx': nrm(ks[9], (DEPTH, GROUP_WIDTH), 0.02),
        'rg_lambda': rg_lambda,
        'dq_norm_g': gain(ks[11], (DEPTH, DIFF_QK_DIM)),
        'dk_norm_g': gain(ks[12], (DEPTH, DIFF_QK_DIM)),
        'lambda_q1': nrm(ks[13], (DEPTH, DIFF_QK_DIM), 0.1),
        'lambda_k1': nrm(ks[14], (DEPTH, DIFF_QK_DIM), 0.1),
        'lambda_q2': nrm(ks[15], (DEPTH, DIFF_QK_DIM), 0.1),
        'lambda_k2': nrm(ks[16], (DEPTH, DIFF_QK_DIM), 0.1),
        'diff_head_norm_g': gain(ks[17], (DEPTH, DIFF_HEAD_DIM)),
        'mem_norm_g': gain(ks[18], (D_MODEL,)),
        'w_mem_kv': nrm(ks[19], (DEPTH, D_MODEL, 2 * GROUP_WIDTH), D_MODEL ** -0.5),
        'mq_norm_g': gain(ks[20], (DEPTH, MEM_HEAD_DIM)),
        'mk_norm_g': gain(ks[21], (DEPTH, MEM_HEAD_DIM)),
        'w_out': nrm(ks[22], (DEPTH, D_MIX, D_MODEL), D_MIX ** -0.5),
        'norm2_g': gain(ks[23], (DEPTH, D_MODEL)),
        'w_router_group': nrm(ks[24], (DEPTH, D_MODEL, N_GROUPS), D_MODEL ** -0.5),
        'b_router_group': nrm(ks[25], (DEPTH, N_GROUPS), 0.01),
        'w_router_expert': nrm(ks[26], (DEPTH, D_MODEL, N_EXPERTS), D_MODEL ** -0.5),
        'b_router_expert': nrm(ks[27], (DEPTH, N_EXPERTS), 0.01),
        'w_expert_gate': nrm(ks[28], (DEPTH, N_EXPERTS, D_MODEL, D_EXPERT), D_MODEL ** -0.5),
        'w_expert_up': nrm(ks[29], (DEPTH, N_EXPERTS, D_MODEL, D_EXPERT), D_MODEL ** -0.5),
        'w_expert_down': nrm(ks[30], (DEPTH, N_EXPERTS, D_EXPERT, D_MODEL), D_EXPERT ** -0.5),
    }


def reference(x, mem, norm1_g, w_in, conv_w, conv_b, rg_wa, rg_ba, rg_wx, rg_bx, rg_lambda,
              dq_norm_g, dk_norm_g, lambda_q1, lambda_k1, lambda_q2, lambda_k2, diff_head_norm_g,
              mem_norm_g, w_mem_kv, mq_norm_g, mk_norm_g, w_out, norm2_g,
              w_router_group, b_router_group, w_router_expert, b_router_expert,
              w_expert_gate, w_expert_up, w_expert_down):
    B, S, _ = x.shape
    M = mem.shape[1]
    memn = rms_norm(mem, mem_norm_g)
    for l in range(DEPTH):
        lam_init = 0.8 - 0.6 * math.exp(-0.3 * l)
        xn = rms_norm(x, norm1_g[l])
        u = xn @ w_in[l]

        y_lru = rg_lru_group(u[..., LRU_X_OFF:LRU_X_OFF + GROUP_WIDTH], u[..., LRU_G_OFF:LRU_G_OFF + GROUP_WIDTH],
                             conv_w[l], conv_b[l], rg_wa[l], rg_ba[l], rg_wx[l], rg_bx[l], rg_lambda[l])

        q = rms_norm(u[..., DIFF_Q_OFF:DIFF_Q_OFF + GROUP_WIDTH].reshape(B, S, DIFF_HEADS, 2, DIFF_QK_DIM), dq_norm_g[l])
        k = rms_norm(u[..., DIFF_K_OFF:DIFF_K_OFF + GROUP_WIDTH].reshape(B, S, DIFF_HEADS, 2, DIFF_QK_DIM), dk_norm_g[l])
        v = u[..., DIFF_V_OFF:DIFF_V_OFF + GROUP_WIDTH].reshape(B, S, DIFF_HEADS, DIFF_HEAD_DIM)
        lam = (jnp.exp(jnp.sum(lambda_q1[l].astype(jnp.float32) * lambda_k1[l].astype(jnp.float32)))
               - jnp.exp(jnp.sum(lambda_q2[l].astype(jnp.float32) * lambda_k2[l].astype(jnp.float32)))
               + lam_init)
        o = diff_attention(q, k, v, lam)
        y_diff = (rms_norm(o, diff_head_norm_g[l]) * (1.0 - lam_init)).reshape(B, S, GROUP_WIDTH)

        mq = rms_norm(u[..., MEM_Q_OFF:MEM_Q_OFF + GROUP_WIDTH].reshape(B, S, MEM_HEADS, MEM_HEAD_DIM), mq_norm_g[l])
        kv = memn @ w_mem_kv[l]
        mk = rms_norm(kv[..., :GROUP_WIDTH].reshape(B, M, MEM_HEADS, MEM_HEAD_DIM), mk_norm_g[l])
        mv = kv[..., GROUP_WIDTH:].reshape(B, M, MEM_HEADS, MEM_HEAD_DIM)
        y_mem = memory_attention(mq, mk, mv)

        x = x + jnp.concatenate([y_lru, y_diff, y_mem], axis=-1) @ w_out[l]

        x = x + hier_moe(rms_norm(x, norm2_g[l]), w_router_group[l], b_router_group[l],
                         w_router_expert[l], b_router_expert[l],
                         w_expert_gate[l], w_expert_up[l], w_expert_down[l])
    return x
```

```cpp
#include <hip/hip_runtime.h>
#include <cstdio>
#include <cstdint>

#ifndef KIND_MASK
#define KIND_MASK 0x7ff
#endif
#define KIND(k) (((KIND_MASK) >> (k)) & 1)
#define LAS __attribute__((address_space(3)))
#define GAS __attribute__((address_space(1)))
typedef unsigned short bf16_t;
typedef short bf16x8 __attribute__((ext_vector_type(8)));
typedef short s16x4 __attribute__((ext_vector_type(4)));
typedef float f32x4 __attribute__((ext_vector_type(4)));
typedef float f32x16 __attribute__((ext_vector_type(16)));
typedef float f32x2 __attribute__((ext_vector_type(2)));
typedef unsigned u32x4 __attribute__((ext_vector_type(4)));
typedef unsigned u32x2 __attribute__((ext_vector_type(2)));
typedef __bf16 bf16x2_t __attribute__((ext_vector_type(2)));

constexpr int BATCH = 8, SEQ = 4096, T = BATCH * SEQ, D = 1024, DIN = 3072, GW = 512, DMIX = 1536, MEML = 256, TM = BATCH * MEML;
constexpr int NEXP = 32, DEXP = 256, NPAIR = 2 * T, DEPTH = 2;
constexpr float EPS = 1e-6f, LOG2E = 1.4426950408889634f;
constexpr int NWAVES = 8, NTHREADS = 512;

__device__ __forceinline__ unsigned cvt_pk(float lo, float hi) { f32x2 v = {lo, hi}; bf16x2_t b = __builtin_convertvector(v, bf16x2_t); return __builtin_bit_cast(unsigned, b); }
__device__ __forceinline__ float bf_lo(unsigned w) { return __uint_as_float(w << 16); }
__device__ __forceinline__ float bf_hi(unsigned w) { return __uint_as_float(w & 0xffff0000u); }
__device__ __forceinline__ float bf1(bf16_t w) { return __uint_as_float((unsigned)w << 16); }
template <int K> __device__ __forceinline__ float xswz(float v) { return __int_as_float(__builtin_amdgcn_ds_swizzle(__float_as_int(v), 0x1f | (K << 10))); }
__device__ __forceinline__ float xhalf(float v) { const unsigned u = __float_as_uint(v); auto rr = __builtin_amdgcn_permlane32_swap(u, u, false, false); const unsigned me = rr[0], ot = rr[1]; return __uint_as_float(me == u ? ot : me); }
__device__ __forceinline__ float xhalf_sum(float v) { const unsigned u = __float_as_uint(v); auto rr = __builtin_amdgcn_permlane32_swap(u, u, false, false); return __uint_as_float(rr[0]) + __uint_as_float(rr[1]); }
__device__ __forceinline__ float xhalf_max(float v) { const unsigned u = __float_as_uint(v); auto rr = __builtin_amdgcn_permlane32_swap(u, u, false, false); return fmaxf(__uint_as_float(rr[0]), __uint_as_float(rr[1])); }
__device__ __forceinline__ float fast_exp2(float x) { return __builtin_amdgcn_exp2f(x); }
__device__ __forceinline__ float fast_rcp(float x) { return __builtin_amdgcn_rcpf(x); }
__device__ __forceinline__ float sigmoidf_(float x) { return fast_rcp(1.f + fast_exp2(-x * LOG2E)); }

namespace pg8 {
#define PG8_LAS __attribute__((address_space(3)))
constexpr int BM = 256, BK = 64, HALF = 128, HTB = HALF * BK * 2, STAGE_BYTES = 8 * HTB, NXCD = 8, WGM = 8;
__host__ __device__ __forceinline__ int lds_byte(int r, int c) { const int st = (r >> 4) * 2 + (c >> 5), rr = r & 15, cc = c & 31, ob = rr * 64 + cc * 2; return st * 1024 + (ob ^ (((ob >> 9) & 1) << 5)); }
__host__ __device__ __forceinline__ void stage_rc(int b, int& R, int& C) { const int st = b / 1024, sb = b % 1024, swz = sb ^ (((sb >> 9) & 1) << 5); R = (st >> 1) * 16 + swz / 64; C = (st & 1) * 32 + (swz % 64) / 2; }
__host__ __device__ __forceinline__ int perm32(int rho) { const int n = rho >> 4, i = rho & 15; return 8 * (i >> 2) + 4 * n + (i & 3); }

struct Unit { const char* a; const char* b; int row0, col0, rows, aux; };

struct StaticOrder {
    int nM, nN, nwg, G, c;
    __device__ void init(int M, int N, int G_, int c_) { nM = M / BM; nN = N / BM; nwg = nM * nN; G = G_; c = c_; }
    __device__ bool next(int i, int& pm, int& pn) const {
        const long L = (long)i * G + c; if (L >= nwg) return false;
        int wgid = (int)L; { const int q = nwg / NXCD, r = nwg % NXCD, xcd = wgid % NXCD, off = wgid / NXCD; wgid = (xcd < r ? xcd * (q + 1) : r * (q + 1) + (xcd - r) * q) + off; }
        const int nig = WGM * nN, gid = wgid / nig, fm = gid * WGM, gsz = (nM - fm) < WGM ? (nM - fm) : WGM;
        pm = fm + ((wgid % nig) % gsz); pn = (wgid % nig) / gsz; return true;
    }
};
struct DenseOrder {
    StaticOrder so; const char* A; const char* Bt; size_t tstep;
    __device__ void init(const bf16_t* A_, const bf16_t* Bt_, int M, int N, int K, int G, int c) { so.init(M, N, G, c); A = (const char*)A_; Bt = (const char*)Bt_; tstep = (size_t)BM * K * 2; }
    __device__ __forceinline__ bool next(int i, Unit& u) const { int pm, pn; if (!so.next(i, pm, pn)) return false; u.a = A + (size_t)pm * tstep; u.b = Bt + (size_t)pn * tstep; u.row0 = pm * BM; u.col0 = pn * BM; u.rows = BM; u.aux = 0; return true; }
    __device__ __forceinline__ void a_ready(const Unit&) const {}
    __device__ __forceinline__ void done(const Unit&) const {}
};
struct MoeOrder {
    const LAS int* cnt; const LAS int* off; const LAS int* ts; const char* A; const char* Bt; int K, NCT, NB, colw, G, c;
    __device__ __forceinline__ bool next(int i, Unit& u) const {
        const int R = __builtin_amdgcn_readfirstlane(ts[NEXP]);
        const long L = (long)i * G + c; if (L >= (long)R * NCT) return false;
        const int rt = (int)(L / NCT), ct = (int)(L % NCT);
        int e = 0;
        for (; e < NEXP - 1; ++e) if (rt < __builtin_amdgcn_readfirstlane(ts[e + 1])) break;
        const int rl = rt - __builtin_amdgcn_readfirstlane(ts[e]);
        const int row0 = __builtin_amdgcn_readfirstlane(off[e]) + BM * rl;
        const int left = __builtin_amdgcn_readfirstlane(cnt[e]) - BM * rl;
        u.a = A + (size_t)row0 * K * 2; u.b = Bt + ((size_t)e * NB + (size_t)ct * BM) * K * 2; u.row0 = row0; u.col0 = ct * colw; u.rows = left < BM ? left : BM; u.aux = e; return true;
    }
    __device__ __forceinline__ void a_ready(const Unit&) const {}
    __device__ __forceinline__ void done(const Unit&) const {}
};


struct EpiIn {
    static constexpr bool PERM = true, AFTER_DRAIN = false;
    bf16_t* O; int ldc; const float* rstd; const float* hg; int hn_lo, hn_hi;
    __device__ __forceinline__ void operator()(const f32x4 (&acc)[2][2][4][2], const Unit& u, int wr, int wc, int fr, int fq) const {
        const int row0 = u.row0 + wr * 64 + fr;
        if (u.col0 >= hn_lo && u.col0 < hn_hi) {
            int fqo = fq; asm volatile("" : "+v"(fqo));
            const float* hgp = hg + 8 * fqo;
#pragma unroll
            for (int ai = 0; ai < 2; ++ai)
#pragma unroll
                for (int m = 0; m < 4; ++m) {
                    const int row = row0 + ai * HALF + m * 16; const float rs = rstd[row];
                    float ss = 0.f;
#pragma unroll
                    for (int bj = 0; bj < 2; ++bj)
#pragma unroll
                        for (int n = 0; n < 2; ++n) { const f32x4 a = acc[ai][bj][m][n]; ss += (a[0] * a[0] + a[1] * a[1]) + (a[2] * a[2] + a[3] * a[3]); }
                    ss += xswz<16>(ss); ss = xhalf_sum(ss);
                    const float sc = rs * __builtin_amdgcn_rsqf(ss * rs * rs * (1.f / 64.f) + EPS);
                    const unsigned off = (unsigned)row * (unsigned)ldc + (unsigned)(u.col0 + 64 * wc + 8 * fq);
#pragma unroll
                    for (int bj = 0; bj < 2; ++bj) { const f32x4 g0 = *(const f32x4*)(hgp + 32 * bj), g1 = *(const f32x4*)(hgp + 32 * bj + 4);
                        const f32x4 a0 = acc[ai][bj][m][0] * sc * g0, a1 = acc[ai][bj][m][1] * sc * g1;
                        u32x4 w; w.x = cvt_pk(a0[0], a0[1]); w.y = cvt_pk(a0[2], a0[3]); w.z = cvt_pk(a1[0], a1[1]); w.w = cvt_pk(a1[2], a1[3]);
                        *(u32x4*)(O + off + 32 * bj) = w; }
                }
        } else {
#pragma unroll
            for (int ai = 0; ai < 2; ++ai)
#pragma unroll
                for (int m = 0; m < 4; ++m) {
                    const int row = row0 + ai * HALF + m * 16; const float rs = rstd[row];
                    const unsigned off = (unsigned)row * (unsigned)ldc + (unsigned)(u.col0 + 32 * wc + 8 * fq);
#pragma unroll
                    for (int bj = 0; bj < 2; ++bj) { const f32x4 a0 = acc[ai][bj][m][0] * rs, a1 = acc[ai][bj][m][1] * rs;
                        u32x4 w; w.x = cvt_pk(a0[0], a0[1]); w.y = cvt_pk(a0[2], a0[3]); w.z = cvt_pk(a1[0], a1[1]); w.w = cvt_pk(a1[2], a1[3]);
                        *(u32x4*)(O + off + bj * HALF) = w; }
                }
        }
    }
};
struct EpiOutRes {
    static constexpr bool PERM = false, AFTER_DRAIN = false;
    const float* base; float* out; int ldc;
    __device__ __forceinline__ void operator()(const f32x4 (&acc)[2][2][4][2], const Unit& u, int wr, int wc, int fr, int fq) const {
        const int row0 = u.row0 + wr * 64 + fr, col0 = u.col0 + wc * 32 + 4 * fq;
#pragma unroll
        for (int ai = 0; ai < 2; ++ai)
#pragma unroll
            for (int m = 0; m < 4; ++m) { const size_t off = (size_t)(row0 + ai * HALF + m * 16) * ldc + col0;
#pragma unroll
                for (int bj = 0; bj < 2; ++bj)
#pragma unroll
                    for (int n = 0; n < 2; ++n) { const f32x4 bs = *(const f32x4*)(base + off + bj * HALF + n * 16); *(f32x4*)(out + off + bj * HALF + n * 16) = bs + acc[ai][bj][m][n]; } }
    }
};
struct EpiMoe1 {
    static constexpr bool PERM = true, AFTER_DRAIN = false;
    bf16_t* Hh; const float* pr; const float* pw;
    __device__ __forceinline__ void operator()(const f32x4 (&acc)[2][2][4][2], const Unit& u, int wr, int wc, int fr, int fq) const {
#pragma unroll
        for (int ai = 0; ai < 2; ++ai)
#pragma unroll
            for (int m = 0; m < 4; ++m) {
                const int rl = ai * HALF + wr * 64 + m * 16 + fr;
                if (rl < u.rows) {
                    const int p = u.row0 + rl; const float rs = pr[p], w = pw[p];
                    float hv[8];
#pragma unroll
                    for (int n = 0; n < 2; ++n)
#pragma unroll
                        for (int j = 0; j < 4; ++j) { const float g = acc[ai][0][m][n][j] * rs, up = acc[ai][1][m][n][j] * rs; hv[4 * n + j] = g * sigmoidf_(g) * up * w; }
                    u32x4 o; o.x = cvt_pk(hv[0], hv[1]); o.y = cvt_pk(hv[2], hv[3]); o.z = cvt_pk(hv[4], hv[5]); o.w = cvt_pk(hv[6], hv[7]);
                    *(u32x4*)(Hh + (size_t)p * DEXP + u.col0 + 32 * wc + 8 * fq) = o;
                }
            }
    }
};
struct EpiMoe2 {
    static constexpr bool PERM = true, AFTER_DRAIN = false;
    bf16_t* YP;
    __device__ __forceinline__ void operator()(const f32x4 (&acc)[2][2][4][2], const Unit& u, int wr, int wc, int fr, int fq) const {
#pragma unroll
        for (int ai = 0; ai < 2; ++ai)
#pragma unroll
            for (int m = 0; m < 4; ++m) {
                const int rl = ai * HALF + wr * 64 + m * 16 + fr;
                if (rl < u.rows) {
                    bf16_t* rowp = YP + (size_t)(u.row0 + rl) * D + u.col0 + 32 * wc + 8 * fq;
#pragma unroll
                    for (int bj = 0; bj < 2; ++bj) { const f32x4 a0 = acc[ai][bj][m][0], a1 = acc[ai][bj][m][1];
                        u32x4 w; w.x = cvt_pk(a0[0], a0[1]); w.y = cvt_pk(a0[2], a0[3]); w.z = cvt_pk(a1[0], a1[1]); w.w = cvt_pk(a1[2], a1[3]);
                        *(u32x4*)(rowp + bj * HALF) = w; }
                }
            }
    }
};

template <class Epi, class Sched, bool ALIGN_EPI = false, bool SP2 = false>
__device__ __forceinline__ void gemm_phase(PG8_LAS unsigned char* lds, const int K, const Sched& S, const Epi& E) {
    int tid_ = threadIdx.x; asm volatile("" : "+v"(tid_));
    const int tid = tid_, wid = __builtin_amdgcn_readfirstlane(tid >> 6), lane = tid & 63, wr = wid >> 2, wc = wid & 3, fr = lane & 15, fq = lane >> 4;
    const int nt = K / BK;
    unsigned voffA[2], voffB[2];
#pragma unroll
    for (int i = 0; i < 2; ++i) { int R, C; stage_rc(tid * 16 + i * 8192, R, C); const int Rb = Epi::PERM ? ((R & ~31) + perm32(R & 31)) : R;
        voffA[i] = (unsigned)(R * K + C) * 2u; voffB[i] = (unsigned)(Rb * K + C) * 2u; }
    const size_t kstep = (size_t)(BK * 2);
    const size_t hstep = (size_t)HALF * K * 2;
    const unsigned ldsw = (unsigned)wid * 1024u;
    const int aoff = lds_byte(wr * 64 + fr, fq * 8), boff = lds_byte(wc * 32 + fr, fq * 8);
#define PG8_SA(b, h) (((b) * 2 + (h)) * HTB)
#define PG8_SB(b, h) ((4 + (b) * 2 + (h)) * HTB)
#define PG8_STAGE(bufoff, gbase, voff) do { _Pragma("unroll") for (int _i = 0; _i < 2; ++_i) \
        __builtin_amdgcn_global_load_lds((const unsigned*)((const char*)(gbase) + (voff)[_i]), (PG8_LAS unsigned*)(lds + (bufoff) + ldsw + _i * 8192), 16, 0, 0); } while (0)
#define PG8_LDA(dst, b, h) do { _Pragma("unroll") for (int m = 0; m < 4; ++m) _Pragma("unroll") for (int k = 0; k < 2; ++k) dst[m][k] = *(const PG8_LAS bf16x8*)(lds + PG8_SA(b, h) + aoff + m * 2048 + k * 1024); } while (0)
#define PG8_LDB(dst, b, h) do { _Pragma("unroll") for (int n = 0; n < 2; ++n) _Pragma("unroll") for (int k = 0; k < 2; ++k) dst[n][k] = *(const PG8_LAS bf16x8*)(lds + PG8_SB(b, h) + boff + n * 2048 + k * 1024); } while (0)
#define PG8_MMA(ai, bj, At, Bt) do { __builtin_amdgcn_s_setprio(1); _Pragma("unroll") for (int m = 0; m < 4; ++m) _Pragma("unroll") for (int n = 0; n < 2; ++n) _Pragma("unroll") for (int k = 0; k < 2; ++k) \
        acc[ai][bj][m][n] = __builtin_amdgcn_mfma_f32_16x16x32_bf16(Bt[n][k], At[m][k], acc[ai][bj][m][n], 0, 0, 0); __builtin_amdgcn_s_setprio(0); } while (0)
#define PG8_WAIT_V(n) asm volatile("s_waitcnt vmcnt(" #n ")" ::: "memory")
#define PG8_WAIT_L(n) asm volatile("s_waitcnt lgkmcnt(" #n ")" ::: "memory")
#define PG8_BAR __builtin_amdgcn_s_barrier()
#define PG8_SCHED __builtin_amdgcn_sched_barrier(0)
    Unit cur, nxt; int ui = 0;
    if (!S.next(0, cur)) return;
    asm volatile("" : "+s"(cur.a), "+s"(cur.b));
    f32x4 acc[2][2][4][2];
#pragma unroll
    for (int a = 0; a < 2; ++a)
#pragma unroll
        for (int b = 0; b < 2; ++b)
#pragma unroll
            for (int m = 0; m < 4; ++m)
#pragma unroll
                for (int n = 0; n < 2; ++n) acc[a][b][m][n] = (f32x4){0.f, 0.f, 0.f, 0.f};
    bf16x8 At[4][2], B0[2][2], B1[2][2];
    const char* cA = cur.a; const char* cB = cur.b;
    S.a_ready(cur);
    if constexpr (SP2) {
        PG8_STAGE(PG8_SB(0, 0), cB, voffB); PG8_STAGE(PG8_SB(0, 1), cB + hstep, voffB); PG8_STAGE(PG8_SA(0, 0), cA, voffA); PG8_STAGE(PG8_SA(0, 1), cA + hstep, voffA);
        if (wr == 1) PG8_BAR;
        PG8_WAIT_V(2); PG8_BAR;
        PG8_STAGE(PG8_SB(1, 0), cB + kstep, voffB); PG8_STAGE(PG8_SA(1, 0), cA + kstep, voffA); PG8_STAGE(PG8_SB(1, 1), cB + hstep + kstep, voffB);
        PG8_WAIT_V(6); PG8_BAR;
    } else {
        PG8_STAGE(PG8_SB(0, 0), cB, voffB); PG8_STAGE(PG8_SA(0, 0), cA, voffA); PG8_STAGE(PG8_SB(0, 1), cB + hstep, voffB); PG8_STAGE(PG8_SA(0, 1), cA + hstep, voffA);
        if (wr == 1) PG8_BAR;
        PG8_WAIT_V(4); PG8_BAR;
        PG8_STAGE(PG8_SB(1, 0), cB + kstep, voffB); PG8_STAGE(PG8_SA(1, 0), cA + kstep, voffA); PG8_STAGE(PG8_SB(1, 1), cB + hstep + kstep, voffB);
        PG8_WAIT_V(6); PG8_BAR;
    }
    for (;;) {
        const bool has_next = S.next(ui + 1, nxt);
        const char* nA = has_next ? nxt.a : cA; const char* nB = has_next ? nxt.b : cB;
        for (int t = 0; t < nt; t += 2) {
            const bool last = (t == nt - 2);
            const char* a1 = cA + (size_t)(t + 1) * kstep;
            const char* a2 = last ? nA : cA + (size_t)(t + 2) * kstep; const char* b2 = last ? nB : cB + (size_t)(t + 2) * kstep;
            const char* a3 = a2 + kstep; const char* b3 = b2 + kstep;
            if (last && has_next) S.a_ready(nxt);
            if constexpr (SP2) {
            PG8_LDB(B0, 0, 0); PG8_LDB(B1, 0, 1); PG8_SCHED; PG8_LDA(At, 0, 0); PG8_STAGE(PG8_SA(1, 1), a1 + hstep, voffA);
            PG8_WAIT_V(8); PG8_WAIT_L(0); PG8_BAR; PG8_MMA(0, 0, At, B0); PG8_MMA(0, 1, At, B1); PG8_BAR; PG8_SCHED;
            PG8_LDA(At, 0, 1); PG8_STAGE(PG8_SB(0, 0), b2, voffB); PG8_STAGE(PG8_SB(0, 1), b2 + hstep, voffB); PG8_STAGE(PG8_SA(0, 0), a2, voffA);
            PG8_WAIT_V(8); PG8_WAIT_L(0); PG8_BAR; PG8_MMA(1, 0, At, B0); PG8_MMA(1, 1, At, B1); PG8_BAR; PG8_SCHED;
            PG8_LDB(B0, 1, 0); PG8_LDB(B1, 1, 1); PG8_SCHED; PG8_LDA(At, 1, 0); PG8_STAGE(PG8_SA(0, 1), a2 + hstep, voffA);
            PG8_WAIT_V(8); PG8_WAIT_L(0); PG8_BAR; PG8_MMA(0, 0, At, B0); PG8_MMA(0, 1, At, B1); PG8_BAR; PG8_SCHED;
            PG8_LDA(At, 1, 1); PG8_STAGE(PG8_SB(1, 0), b3, voffB); PG8_STAGE(PG8_SB(1, 1), b3 + hstep, voffB); PG8_STAGE(PG8_SA(1, 0), a3, voffA);
            PG8_WAIT_V(8); PG8_WAIT_L(0); PG8_BAR; PG8_MMA(1, 0, At, B0); PG8_MMA(1, 1, At, B1); PG8_BAR; PG8_SCHED;
            } else {
            PG8_LDB(B0, 0, 0); PG8_SCHED; PG8_LDA(At, 0, 0); PG8_STAGE(PG8_SA(1, 1), a1 + hstep, voffA);
            PG8_WAIT_L(8); PG8_BAR; PG8_WAIT_L(0); PG8_MMA(0, 0, At, B0); PG8_BAR; PG8_SCHED;
            PG8_LDB(B1, 0, 1); PG8_STAGE(PG8_SB(0, 0), b2, voffB);
            PG8_BAR; PG8_WAIT_L(0); PG8_MMA(0, 1, At, B1); PG8_BAR;
            PG8_LDA(At, 0, 1); PG8_STAGE(PG8_SA(0, 0), a2, voffA);
            PG8_BAR; PG8_WAIT_L(0); PG8_MMA(1, 0, At, B0); PG8_BAR; PG8_SCHED;
            PG8_STAGE(PG8_SB(0, 1), b2 + hstep, voffB);
            PG8_WAIT_V(6); PG8_BAR; PG8_MMA(1, 1, At, B1); PG8_BAR;
            PG8_LDB(B0, 1, 0); PG8_SCHED; PG8_LDA(At, 1, 0); PG8_STAGE(PG8_SA(0, 1), a2 + hstep, voffA);
            PG8_WAIT_L(8); PG8_BAR; PG8_WAIT_L(0); PG8_MMA(0, 0, At, B0); PG8_BAR; PG8_SCHED;
            PG8_LDB(B1, 1, 1); PG8_STAGE(PG8_SB(1, 0), b3, voffB);
            PG8_BAR; PG8_WAIT_L(0); PG8_MMA(0, 1, At, B1); PG8_BAR;
            PG8_LDA(At, 1, 1); PG8_STAGE(PG8_SA(1, 0), a3, voffA);
            PG8_BAR; PG8_WAIT_L(0); PG8_MMA(1, 0, At, B0); PG8_BAR; PG8_SCHED;
            PG8_STAGE(PG8_SB(1, 1), b3 + hstep, voffB);
            PG8_WAIT_V(6); PG8_BAR; PG8_MMA(1, 1, At, B1); PG8_BAR;
            }
        }
        if constexpr (ALIGN_EPI) { if (wr == 0) PG8_BAR; }
        if constexpr (!Epi::AFTER_DRAIN) { E(acc, cur, wr, wc, fr, fq); S.done(cur); }
        if (!has_next) break;
#pragma unroll
        for (int a = 0; a < 2; ++a)
#pragma unroll
            for (int b = 0; b < 2; ++b)
#pragma unroll
                for (int m = 0; m < 4; ++m)
#pragma unroll
                    for (int n = 0; n < 2; ++n) acc[a][b][m][n] = (f32x4){0.f, 0.f, 0.f, 0.f};
        cur = nxt; cA = nA; cB = nB; ++ui;
        if constexpr (ALIGN_EPI) { if (wr == 1) PG8_BAR; }
    }
    PG8_WAIT_V(0);
    if constexpr (!ALIGN_EPI) { if (wr == 0) PG8_BAR; }
    PG8_BAR;
    if constexpr (Epi::AFTER_DRAIN) { E.fused(acc, cur, wr, wc, fr, fq, lds, wid, lane); S.done(cur); }
#undef PG8_SA
#undef PG8_SB
#undef PG8_STAGE
#undef PG8_LDA
#undef PG8_LDB
#undef PG8_MMA
#undef PG8_WAIT_V
#undef PG8_WAIT_L
#undef PG8_BAR
#undef PG8_SCHED
}
}

constexpr size_t MiB = 1u << 20, KiB = 1u << 10;
constexpr size_t WS_CTL = 0, CTL_ZERO_BYTES = 1 * MiB;
constexpr size_t WS_RSTDX = 1 * MiB, WS_RSTD2 = WS_RSTDX + 128 * KiB, WS_RSTDM = WS_RSTD2 + 128 * KiB, WS_TOKPAIR = 1 * MiB + 512 * KiB;
constexpr size_t WS_ROUTE = 2 * MiB;
constexpr size_t WS_PAIRR = 3 * MiB, WS_PAIRW = 3 * MiB + 512 * KiB;
constexpr size_t WS_WR = 4 * MiB;
constexpr size_t WS_MEMB = 5 * MiB;
constexpr size_t WS_KVB = 9 * MiB;
constexpr size_t WS_WIN = 17 * MiB, WS_WOUT = 29 * MiB, WS_WKV = 35 * MiB, WS_WGU = 39 * MiB, WS_WD = 103 * MiB;
constexpr size_t WS_XB = 135 * MiB;
constexpr size_t WS_Y = 199 * MiB, WS_H = WS_Y;
constexpr size_t WS_U = 295 * MiB, WS_XG = WS_U, WS_YP = WS_U;
constexpr size_t WS_END = 487 * MiB;
static_assert(WS_U + (size_t)T * DIN * 2 <= WS_END && WS_XG + (size_t)(NPAIR + 256) * D * 2 <= WS_END && WS_H + (size_t)(NPAIR + 256) * DEXP * 2 <= WS_U, "d_ws map");
static_assert(WS_WD + (size_t)2 * NEXP * D * DEXP * 2 <= WS_XB && WS_WGU + (size_t)2 * NEXP * 512 * D * 2 <= WS_WD, "d_ws map (weights)");
constexpr int CW_BAR = 4096, CW_GCNT = 8192;

constexpr int RING_BYTES = 131072;
constexpr int TAB_OFF = RING_BYTES;
constexpr int TI_CNT = 0, TI_OFF = 64, TI_TS = 128, TI_HIST = 192, TI_BASE = 256;
constexpr int TF_BASE = 512;
constexpr int TF_GQ = TF_BASE, TF_DHG = TF_GQ + 64, TF_MQG = TF_DHG + 128, TF_MKG = TF_MQG + 128, TF_SC = TF_MKG + 128;
constexpr int MISC_OFF = TAB_OFF + 8192;
constexpr int LDS_BYTES = 147456;
static_assert((TF_SC + 16) * 4 <= 8192 && MISC_OFF + 128 <= LDS_BYTES, "LDS map");

typedef GAS unsigned gu32;
#define LDS_WAIT() asm volatile("s_waitcnt lgkmcnt(0)" ::: "memory")

#define XB_TMO      128
#define XB_XCNT(j)  (256  + 64 * (j))
#define XB_XSUB(j)  (1280 + 64 * (j))
#define XB_XGEN(j)  (2304 + 64 * (j))
#define XB_TOP      3328
#define XB_TOPGEN   3392
#define XCD_BAR_WORDS 3456
#define XB_SPIN_CAP (1u << 18)
__device__ __forceinline__ unsigned xb_ld(unsigned* p)              { return __hip_atomic_load(p, __ATOMIC_RELAXED, __HIP_MEMORY_SCOPE_AGENT); }
__device__ __forceinline__ unsigned xb_add(unsigned* p, unsigned v) { return __hip_atomic_fetch_add(p, v, __ATOMIC_RELAXED, __HIP_MEMORY_SCOPE_AGENT); }
__device__ __forceinline__ unsigned xb_xcc_id() { return (unsigned)__builtin_amdgcn_s_getreg((3 << 11) | 20) & 0xFu; }
#define XB_SPIN(cond, bar) do { unsigned _sp = 0; while (cond) { __builtin_amdgcn_s_sleep(1); \
    if ((++_sp & 255u) == 0u) { if (xb_ld(&(bar)[XB_TMO])) break; if (_sp > XB_SPIN_CAP) { atomicAdd(&(bar)[XB_TMO], 1u); break; } } } } while (0)

struct XcdBarrier {
    unsigned* bar; unsigned x;
    volatile LAS unsigned* st;
};

__device__ __forceinline__ XcdBarrier xcd_barrier_post(unsigned* bar, volatile LAS unsigned* st) {
    XcdBarrier b; b.bar = bar; b.x = xb_xcc_id(); b.st = st;
    if (threadIdx.x == 0) (void)xb_add(&bar[XB_XCNT(b.x)], 1u);
    return b;
}
__device__ __forceinline__ void xcd_barrier_complete(unsigned* bar, unsigned x, unsigned& nloc, unsigned& nx) {
    const unsigned G = gridDim.x * gridDim.y * gridDim.z;
    unsigned sum, cnt, mine, sp = 0u;
    for (;;) {
        sum = 0u; cnt = 0u; mine = 0u;
#pragma unroll
        for (unsigned j = 0; j < 16; ++j) { const unsigned c = xb_ld(&bar[XB_XCNT(j)]); sum += c; cnt += (c > 0u) ? 1u : 0u; mine = (j == x) ? c : mine; }
        if (sum == G) break;
        __builtin_amdgcn_s_sleep(1);
        if ((++sp & 255u) == 0u) { if (xb_ld(&bar[XB_TMO])) break; if (sp > XB_SPIN_CAP) { atomicAdd(&bar[XB_TMO], 1u); break; } }
    }
    nloc = mine > 0u ? mine : 1u; nx = cnt > 0u ? cnt : 1u;
}

__device__ __forceinline__ void xcd_barrier(const XcdBarrier& b) {
    asm volatile("s_waitcnt vmcnt(0)" ::: "memory");
    __syncthreads();
    if (threadIdx.x == 0) {
        unsigned* bar = b.bar;
        __builtin_amdgcn_s_waitcnt(0);
        unsigned nloc = b.st[0], nx = b.st[1];
        if (nloc == 0u) { xcd_barrier_complete(bar, b.x, nloc, nx); b.st[0] = nloc; b.st[1] = nx; }
        const unsigned old = xb_add(&bar[XB_XSUB(b.x)], 1u);
        const unsigned gen = old / nloc;
        if (old + 1u == (gen + 1u) * nloc) {
            __builtin_amdgcn_fence(__ATOMIC_RELEASE, "agent");
            asm volatile("s_waitcnt vmcnt(0)" ::: "memory");
            const unsigned og = xb_add(&bar[XB_TOP], 1u);
            const unsigned tg = og / nx;
            if (og + 1u == (tg + 1u) * nx) xb_add(&bar[XB_TOPGEN], 1u);
            else XB_SPIN(xb_ld(&bar[XB_TOPGEN]) == tg, bar);
            __builtin_amdgcn_fence(__ATOMIC_ACQUIRE, "agent");
            xb_add(&bar[XB_XGEN(b.x)], 1u);
            asm volatile("s_waitcnt vmcnt(0)" ::: "memory");
        } else {
            XB_SPIN(xb_ld(&bar[XB_XGEN(b.x)]) == gen, bar);
            __builtin_amdgcn_fence(__ATOMIC_ACQUIRE, "agent");
            asm volatile("s_waitcnt vmcnt(0)" ::: "memory");
        }
    }
    __syncthreads();
}

struct Ctx {
    LAS unsigned char* lds; LAS int* ti; LAS float* tf;
    int tid, lane, wave, G, vcu;
    float* out; unsigned char* ws;
};
typedef const float* cfp_t;
#define INP(i) (((const __attribute__((address_space(4))) cfp_t*)__builtin_amdgcn_kernarg_segment_ptr())[(i)])
enum InIdx { I_X = 0, I_MEM, I_N1G, I_WIN, I_CONVW, I_CONVB, I_WA, I_BA, I_WX, I_BX, I_LAMBDA, I_DQG, I_DKG, I_LQ1, I_LK1, I_LQ2, I_LK2, I_DHG, I_MEMG, I_WKV, I_MQG, I_MKG, I_WOUT, I_N2G,
             I_WRG, I_BRG, I_WRE, I_BRE, I_WEG, I_WEU, I_WED };
__device__ __forceinline__ float wave_sum(float v) {
    v += xswz<1>(v); v += xswz<2>(v); v += xswz<4>(v); v += xswz<8>(v); v += xswz<16>(v); v = xhalf_sum(v);
    return v;
}
__device__ __forceinline__ float wave_max(float v) {
    v = fmaxf(v, xswz<1>(v)); v = fmaxf(v, xswz<2>(v)); v = fmaxf(v, xswz<4>(v)); v = fmaxf(v, xswz<8>(v)); v = fmaxf(v, xswz<16>(v)); v = xhalf_max(v);
    return v;
}

__device__ __forceinline__ void p0_transpose_item(const float* W, int N, int K, bf16_t* WT, int dst_row0, const float* kscale, LAS float* scr, int k0, int n0, int lane) {
#pragma unroll 8
    for (int i = 0; i < 32; ++i) { const int kk = 2 * i + (lane >> 5); float v = W[(size_t)(k0 + kk) * N + n0 + (lane & 31)]; if (kscale) v *= kscale[k0 + kk]; scr[kk * 33 + (lane & 31)] = v; }
    LDS_WAIT(); asm volatile("" ::: "memory");
    const int c = lane & 7;
#pragma unroll
    for (int j = 0; j < 4; ++j) { const int n = (lane >> 3) + 8 * j; const LAS float* s = scr + (8 * c) * 33 + n;
        u32x4 o; o.x = cvt_pk(s[0 * 33], s[1 * 33]); o.y = cvt_pk(s[2 * 33], s[3 * 33]); o.z = cvt_pk(s[4 * 33], s[5 * 33]); o.w = cvt_pk(s[6 * 33], s[7 * 33]);
        *(u32x4*)(WT + (size_t)(dst_row0 + n) * K + k0 + 8 * c) = o; }
    LDS_WAIT(); asm volatile("" ::: "memory");
}
__device__ __forceinline__ void row_to_bf16(const float* xrow, bf16_t* orow, float* rstd_out, int lane) {
    const f32x4* xr = (const f32x4*)xrow + lane; f32x4 v[4]; float s = 0.f;
#pragma unroll
    for (int j = 0; j < 4; ++j) { v[j] = xr[64 * j]; s += (v[j].x * v[j].x + v[j].y * v[j].y) + (v[j].z * v[j].z + v[j].w * v[j].w); }
    s = wave_sum(s);
    u32x2* o8 = (u32x2*)orow + lane;
#pragma unroll
    for (int j = 0; j < 4; ++j) { u32x2 w; w.x = cvt_pk(v[j].x, v[j].y); w.y = cvt_pk(v[j].z, v[j].w); o8[64 * j] = w; }
    if (lane == 0) *rstd_out = __builtin_amdgcn_rsqf(s * (1.f / D) + EPS);
}
__device__ __forceinline__ void p0_prologue(Ctx& F) {
    LAS float* scr = (LAS float*)(F.lds + F.wave * 16384);
    const int gw = F.vcu * NWAVES + F.wave, NGW = F.G * NWAVES;
    constexpr int I_IN = 16 * 96, I_OUT = 24 * 32, I_KV = 16 * 32, I_G = NEXP * 16 * 8, I_D = NEXP * 4 * 32, PER_L = I_IN + I_OUT + I_KV + 2 * I_G + I_D;
    bf16_t* Win = (bf16_t*)(F.ws + WS_WIN); bf16_t* Wout = (bf16_t*)(F.ws + WS_WOUT); bf16_t* Wkv = (bf16_t*)(F.ws + WS_WKV); bf16_t* Wgu = (bf16_t*)(F.ws + WS_WGU); bf16_t* Wd = (bf16_t*)(F.ws + WS_WD);
    for (int it = gw; it < DEPTH * PER_L; it += NGW) {
        const int l = it / PER_L; int r = it % PER_L;
        if (r < I_IN) { const int kb = r / 96, nb = r % 96, n0 = 32 * nb; int d0 = n0;
            if (n0 >= 1536 && n0 < 2048) { const int lt = n0 & 255, wc = lt >> 6, bj = (lt >> 5) & 1; d0 = (n0 & ~255) + 128 * bj + 32 * wc; }
            p0_transpose_item(INP(I_WIN) + (size_t)l * D * DIN, DIN, D, Win + (size_t)l * DIN * D, d0, INP(I_N1G) + l * D, scr, 64 * kb, n0, F.lane); continue; } r -= I_IN;
        if (r < I_OUT) { const int kb = r / 32, nb = r % 32;
            p0_transpose_item(INP(I_WOUT) + (size_t)l * DMIX * D, D, DMIX, Wout + (size_t)l * D * DMIX, 32 * nb, nullptr, scr, 64 * kb, 32 * nb, F.lane); continue; } r -= I_OUT;
        if (r < I_KV) { const int kb = r / 32, nb = r % 32;
            p0_transpose_item(INP(I_WKV) + (size_t)l * D * 1024, 1024, D, Wkv + (size_t)l * 1024 * D, 32 * nb, INP(I_MEMG), scr, 64 * kb, 32 * nb, F.lane); continue; } r -= I_KV;
        if (r < 2 * I_G) { const int up = r >= I_G; if (up) r -= I_G; const int e = r / 128, q = r % 128, kb = q / 8, nb = q % 8, n0 = 32 * nb;
            const int d0 = 256 * (n0 >> 7) + (n0 & 127) + (up ? 128 : 0);
            p0_transpose_item(INP(up ? I_WEU : I_WEG) + ((size_t)l * NEXP + e) * D * DEXP, DEXP, D, Wgu + ((size_t)l * NEXP + e) * 512 * D, d0, INP(I_N2G) + l * D, scr, 64 * kb, n0, F.lane); continue; } r -= 2 * I_G;
        { const int e = r / 128, q = r % 128, kb = q / 32, nb = q % 32;
            p0_transpose_item(INP(I_WED) + ((size_t)l * NEXP + e) * DEXP * D, D, DEXP, Wd + ((size_t)l * NEXP + e) * D * DEXP, 32 * nb, nullptr, scr, 64 * kb, 32 * nb, F.lane); }
    }
    for (int m = gw; m < T; m += NGW) row_to_bf16(INP(I_X) + (size_t)m * D, (bf16_t*)(F.ws + WS_XB) + (size_t)m * D, (float*)(F.ws + WS_RSTDX) + m, F.lane);
    for (int m = gw; m < TM; m += NGW) row_to_bf16(INP(I_MEM) + (size_t)m * D, (bf16_t*)(F.ws + WS_MEMB) + (size_t)m * D, (float*)(F.ws + WS_RSTDM) + m, F.lane);
    float* Wr = (float*)(F.ws + WS_WR);
    for (int idx = (F.vcu * NTHREADS + F.tid); idx < DEPTH * 48 * D; idx += F.G * NTHREADS) {
        const int l = idx / (48 * D), rem = idx % (48 * D), n = rem / D, k = rem % D; float v = 0.f;
        if (n < 4) v = INP(I_WRG)[((size_t)l * D + k) * 4 + n]; else if (n < 36) v = INP(I_WRE)[((size_t)l * D + k) * NEXP + (n - 4)];
        Wr[idx] = v * INP(I_N2G)[l * D + k];
    }
}

namespace att {
constexpr int KCH = 1040;
constexpr int KIMG = 8 * KCH;
constexpr int VDC = 4160;
constexpr int VOFF = 2 * KIMG;
constexpr int BUF = VOFF + 4 * VDC;
static_assert(2 * BUF <= RING_BYTES && 4 * 16384 <= 2 * BUF, "attention LDS");
typedef short v4i16_t __attribute__((ext_vector_type(4)));
__device__ __forceinline__ f32x16 mfma32(bf16x8 a, bf16x8 b, f32x16 c) { return __builtin_amdgcn_mfma_f32_32x32x16_bf16(a, b, c, 0, 0, 0); }
__device__ __forceinline__ s16x4 vtr(const LAS unsigned char* p) { return __builtin_bit_cast(s16x4, __builtin_amdgcn_ds_read_tr16_b64_v4i16((LAS v4i16_t*)p)); }

template <int NS>
__device__ __forceinline__ void tile(const LAS unsigned char* kimg, const LAS unsigned char* vimg, const bf16x8 (&qf)[NS], f32x16 (&oT)[4], float& lsum, float negb, int lane, bool domask, int qi, int kv0) {
    const int i = lane & 31, h = lane >> 5;
    const int pi = (i & 0x13) | ((i & 4) << 1) | ((i & 8) >> 1);
    const LAS unsigned char* kb = kimg + h * KCH + pi * 16;
    const int qq = (lane & 15) >> 2, pp = lane & 3, blk = (lane >> 4) & 1;
    const LAS unsigned char* vb = vimg + (8 * h + qq) * 64 + blk * 32 + pp * 8;
#pragma unroll
    for (int hf = 0; hf < 2; ++hf) {
        f32x16 s;
#pragma unroll
        for (int r = 0; r < 16; ++r) s[r] = negb;
#pragma unroll
        for (int sl = 0; sl < NS; ++sl) { const bf16x8 kf = *(const LAS bf16x8*)(kb + sl * 2 * KCH + hf * 512); s = mfma32(kf, qf[sl], s); }
        float p[16];
#pragma unroll
        for (int r = 0; r < 16; ++r) p[r] = fast_exp2(s[r]);
        if (domask) {
#pragma unroll
            for (int r = 0; r < 16; ++r) { const int kv = kv0 + 32 * hf + 16 * (r >> 3) + 8 * h + (r & 7); if (kv > qi) p[r] = 0.f; }
        }
        float ps = 0.f;
#pragma unroll
        for (int r = 0; r < 16; ++r) ps += p[r];
        lsum += ps;
        bf16x8 pk[2];
#pragma unroll
        for (int sp = 0; sp < 2; ++sp) { u32x4 w; w.x = cvt_pk(p[8 * sp + 0], p[8 * sp + 1]); w.y = cvt_pk(p[8 * sp + 2], p[8 * sp + 3]); w.z = cvt_pk(p[8 * sp + 4], p[8 * sp + 5]); w.w = cvt_pk(p[8 * sp + 6], p[8 * sp + 7]); pk[sp] = __builtin_bit_cast(bf16x8, w); }
#pragma unroll
        for (int sp = 0; sp < 2; ++sp)
#pragma unroll
            for (int dc = 0; dc < 4; ++dc) {
                const s16x4 lo = vtr(vb + dc * VDC + (2 * hf + sp) * 1024), hi = vtr(vb + dc * VDC + (2 * hf + sp) * 1024 + 256);
                const bf16x8 vf = {lo[0], lo[1], lo[2], lo[3], hi[0], hi[1], hi[2], hi[3]};
                oT[dc] = mfma32(vf, pk[sp], oT[dc]);
            }
    }
}
__device__ __forceinline__ void stage_write(LAS unsigned char* buf, const u32x4 (&v)[4], int tid) {
    const int r16 = tid >> 4, c16 = tid & 15;
#pragma unroll
    for (int i = 0; i < 2; ++i) { const int kv = r16 + 32 * i;
        *(LAS u32x4*)(buf + c16 * KCH + kv * 16) = v[i];
        *(LAS u32x4*)(buf + VOFF + (c16 >> 2) * VDC + (kv >> 4) * 1024 + (kv & 15) * 64 + (c16 & 3) * 16) = v[2 + i]; }
}

__device__ __forceinline__ void diff_unit(Ctx& F, int l, int b, int hd, int qb) {
    const int tid = F.tid, lane = F.lane, wave = F.wave, qg = wave >> 1, c = wave & 1;
    const bf16_t* U = (const bf16_t*)(F.ws + WS_U); bf16_t* Y = (bf16_t*)(F.ws + WS_Y);
    const int tok0 = b * SEQ, q0 = 128 * qb, NT = 2 * qb + 2;
    const float lam = F.tf[TF_SC + 0], negb = -F.tf[TF_SC + 1];
    const float lam_init = (l == 0) ? 0.2f : 0.35550907f;
    bf16x8 qf[4];
    { const bf16_t* qrow = U + (size_t)(tok0 + q0 + 32 * qg + (lane & 31)) * DIN + 1024 + hd * 128 + c * 64 + 8 * (lane >> 5);
      u32x4 raw[4]; float ss = 0.f;
#pragma unroll
      for (int s = 0; s < 4; ++s) { raw[s] = *(const u32x4*)(qrow + 16 * s);
#pragma unroll
          for (int j = 0; j < 4; ++j) { const float a = bf_lo(raw[s][j]), bb = bf_hi(raw[s][j]); ss += a * a + bb * bb; } }
      ss = xhalf_sum(ss);
      const float rq = __builtin_amdgcn_rsqf(ss * (1.f / 64.f) + EPS) * (0.125f * LOG2E);
#pragma unroll
      for (int s = 0; s < 4; ++s) { const LAS float* g = F.tf + TF_GQ + 16 * s + 8 * (lane >> 5); u32x4 w;
#pragma unroll
          for (int j = 0; j < 4; ++j) w[j] = cvt_pk(bf_lo(raw[s][j]) * rq * g[2 * j], bf_hi(raw[s][j]) * rq * g[2 * j + 1]);
          qf[s] = __builtin_bit_cast(bf16x8, w); } }
    f32x16 oT[4];
#pragma unroll
    for (int dc = 0; dc < 4; ++dc)
#pragma unroll
        for (int r = 0; r < 16; ++r) oT[dc][r] = 0.f;
    float lsum = 0.f;
    const int r16 = tid >> 4, c16 = tid & 15;
    const bf16_t* kp = U + (size_t)(tok0 + r16) * DIN + 1536 + hd * 128 + c16 * 8;
    u32x4 st[4];
#define DIFF_LOAD(jt) do { const bf16_t* p_ = kp + (size_t)(64 * (jt)) * DIN; st[0] = *(const u32x4*)p_; st[1] = *(const u32x4*)(p_ + (size_t)32 * DIN); st[2] = *(const u32x4*)(p_ + 512); st[3] = *(const u32x4*)(p_ + (size_t)32 * DIN + 512); } while (0)
    DIFF_LOAD(0);
    stage_write(F.lds, st, tid);
    __syncthreads();
    const int qlo = q0 + 32 * qg, qi = qlo + (lane & 31);
    for (int jt = 0; jt < NT; ++jt) {
        LAS unsigned char* cur = F.lds + (jt & 1) * BUF; LAS unsigned char* nxt = F.lds + ((jt + 1) & 1) * BUF;
        if (jt + 1 < NT) DIFF_LOAD(jt + 1);
        if (64 * jt <= qlo + 31) tile<4>(cur + c * KIMG, cur + VOFF, qf, oT, lsum, negb, lane, 64 * jt + 63 > qlo, qi, 64 * jt);
        if (jt + 1 < NT) stage_write(nxt, st, tid);
        __syncthreads();
    }
#undef DIFF_LOAD
    lsum = xhalf_sum(lsum);
    const float inv = fast_rcp(lsum);
    LAS float* xb = (LAS float*)F.lds + (size_t)qg * 4096 + lane;
    if (c == 1) { const float sc = inv * lam;
#pragma unroll
        for (int dc = 0; dc < 4; ++dc)
#pragma unroll
            for (int r = 0; r < 16; ++r) xb[(dc * 16 + r) * 64] = oT[dc][r] * sc; }
    __syncthreads();
    if (c == 0) { float ss = 0.f;
#pragma unroll
        for (int dc = 0; dc < 4; ++dc)
#pragma unroll
            for (int r = 0; r < 16; ++r) { const float d = oT[dc][r] * inv - xb[(dc * 16 + r) * 64]; oT[dc][r] = d; ss += d * d; }
        ss = xhalf_sum(ss);
        const float rr = __builtin_amdgcn_rsqf(ss * (1.f / 128.f) + EPS) * (1.f - lam_init);
        bf16_t* yrow = Y + (size_t)(tok0 + qi) * DMIX + 512 + hd * 128 + 4 * (lane >> 5);
#pragma unroll
        for (int dc = 0; dc < 4; ++dc)
#pragma unroll
            for (int g4 = 0; g4 < 4; ++g4) { const f32x4 g = *(const LAS f32x4*)(F.tf + TF_DHG + 32 * dc + 8 * g4 + 4 * (lane >> 5));
                u32x2 w; w.x = cvt_pk(oT[dc][4 * g4 + 0] * rr * g[0], oT[dc][4 * g4 + 1] * rr * g[1]); w.y = cvt_pk(oT[dc][4 * g4 + 2] * rr * g[2], oT[dc][4 * g4 + 3] * rr * g[3]);
                *(u32x2*)(yrow + 32 * dc + 8 * g4) = w; } }
    __syncthreads();
}

__device__ __forceinline__ void mem_unit(Ctx& F, int l, int b, int mh, int qb) {
    const int tid = F.tid, lane = F.lane, wave = F.wave;
    const bf16_t* U = (const bf16_t*)(F.ws + WS_U); bf16_t* Y = (bf16_t*)(F.ws + WS_Y); const bf16_t* KV = (const bf16_t*)(F.ws + WS_KVB);
    const int tok = b * SEQ + 256 * qb + 32 * wave + (lane & 31);
    const float negb = -F.tf[TF_SC + 2];
    bf16x8 qf[8];
    { const bf16_t* qrow = U + (size_t)tok * DIN + 2560 + mh * 128 + 8 * (lane >> 5);
      u32x4 raw[8]; float ss = 0.f;
#pragma unroll
      for (int s = 0; s < 8; ++s) { raw[s] = *(const u32x4*)(qrow + 16 * s);
#pragma unroll
          for (int j = 0; j < 4; ++j) { const float a = bf_lo(raw[s][j]), bb = bf_hi(raw[s][j]); ss += a * a + bb * bb; } }
      ss = xhalf_sum(ss);
      const float rq = __builtin_amdgcn_rsqf(ss * (1.f / 128.f) + EPS) * (0.08838834764831845f * LOG2E);
#pragma unroll
      for (int s = 0; s < 8; ++s) { const LAS float* g = F.tf + TF_MQG + 16 * s + 8 * (lane >> 5); u32x4 w;
#pragma unroll
          for (int j = 0; j < 4; ++j) w[j] = cvt_pk(bf_lo(raw[s][j]) * rq * g[2 * j], bf_hi(raw[s][j]) * rq * g[2 * j + 1]);
          qf[s] = __builtin_bit_cast(bf16x8, w); } }
    f32x16 oT[4];
#pragma unroll
    for (int dc = 0; dc < 4; ++dc)
#pragma unroll
        for (int r = 0; r < 16; ++r) oT[dc][r] = 0.f;
    float lsum = 0.f;
    const int r16 = tid >> 4, c16 = tid & 15;
    const bf16_t* kp = KV + (size_t)(b * MEML + r16) * 2048 + l * 1024 + mh * 128 + c16 * 8;
    const LAS float* gk = F.tf + TF_MKG + 8 * c16;
    u32x4 st[4];
#define MEM_LOAD(jt) do { const bf16_t* p_ = kp + (size_t)(64 * (jt)) * 2048; st[0] = *(const u32x4*)p_; st[1] = *(const u32x4*)(p_ + (size_t)32 * 2048); st[2] = *(const u32x4*)(p_ + 512); st[3] = *(const u32x4*)(p_ + (size_t)32 * 2048 + 512); \
    _Pragma("unroll") for (int i_ = 0; i_ < 2; ++i_) { float f_[8]; float ss_ = 0.f; \
        _Pragma("unroll") for (int j_ = 0; j_ < 4; ++j_) { f_[2 * j_] = bf_lo(st[i_][j_]); f_[2 * j_ + 1] = bf_hi(st[i_][j_]); ss_ += f_[2 * j_] * f_[2 * j_] + f_[2 * j_ + 1] * f_[2 * j_ + 1]; } \
        ss_ += xswz<1>(ss_); ss_ += xswz<2>(ss_); ss_ += xswz<4>(ss_); ss_ += xswz<8>(ss_); \
        const float rk_ = __builtin_amdgcn_rsqf(ss_ * (1.f / 128.f) + EPS); \
        _Pragma("unroll") for (int j_ = 0; j_ < 4; ++j_) st[i_][j_] = cvt_pk(f_[2 * j_] * rk_ * gk[2 * j_], f_[2 * j_ + 1] * rk_ * gk[2 * j_ + 1]); } } while (0)
    for (int jt = 0; jt < 4; ++jt) {
        LAS unsigned char* cur = F.lds + (jt & 1) * BUF;
        MEM_LOAD(jt);
        stage_write(cur, st, tid);
        __syncthreads();
        tile<8>(cur, cur + VOFF, qf, oT, lsum, negb, lane, false, 0, 0);
    }
    __syncthreads();
#undef MEM_LOAD
    lsum = xhalf_sum(lsum);
    const float inv = fast_rcp(lsum);
    bf16_t* yrow = Y + (size_t)tok * DMIX + 1024 + mh * 128 + 4 * (lane >> 5);
#pragma unroll
    for (int dc = 0; dc < 4; ++dc)
#pragma unroll
        for (int g4 = 0; g4 < 4; ++g4) { u32x2 w; w.x = cvt_pk(oT[dc][4 * g4 + 0] * inv, oT[dc][4 * g4 + 1] * inv); w.y = cvt_pk(oT[dc][4 * g4 + 2] * inv, oT[dc][4 * g4 + 3] * inv);
            *(u32x2*)(yrow + 32 * dc + 8 * g4) = w; }
}
}

namespace lru {
constexpr int TC = 256;
constexpr int XRAW = 0, XC = 33280, XCP = 144, GR = XC + TC * XCP, GI = GR + TC * 64, SEGA = GI + TC * 64, SEGB = SEGA + 2048, CARRY = SEGB + 2048, END = CARRY + 64;
static_assert(END <= RING_BYTES, "lru LDS");
__device__ __forceinline__ void unit(Ctx& F, int l, int b, int j, int qtr) {
    const int tid = F.tid, lane = F.lane, wave = F.wave;
    const bf16_t* U = (const bf16_t*)(F.ws + WS_U); bf16_t* Y = (bf16_t*)(F.ws + WS_Y);
    const int tok0 = b * SEQ;
    const int cc = tid & 7, trow = tid >> 3;
    float cw[4][8], cb[8];
#pragma unroll
    for (int k = 0; k < 8; ++k) { cb[k] = INP(I_CONVB)[l * GW + 64 * j + 8 * cc + k];
#pragma unroll
        for (int w = 0; w < 4; ++w) cw[w][k] = INP(I_CONVW)[((size_t)l * 4 + w) * GW + 64 * j + 8 * cc + k]; }
    bf16x8 bA[2], bX[2];
    { const int n = lane & 15, kq = lane >> 4;
      const float* wa = INP(I_WA) + ((size_t)l * 8 + j) * 4096 + 16 * qtr + n; const float* wx = INP(I_WX) + ((size_t)l * 8 + j) * 4096 + 16 * qtr + n;
#pragma unroll
      for (int ks = 0; ks < 2; ++ks) { u32x4 a, x;
#pragma unroll
          for (int jj = 0; jj < 4; ++jj) { const int k0 = 32 * ks + 8 * kq + 2 * jj; a[jj] = cvt_pk(wa[(size_t)k0 * 64], wa[(size_t)(k0 + 1) * 64]); x[jj] = cvt_pk(wx[(size_t)k0 * 64], wx[(size_t)(k0 + 1) * 64]); }
          bA[ks] = __builtin_bit_cast(bf16x8, a); bX[ks] = __builtin_bit_cast(bf16x8, x); } }
    const float ba_n = INP(I_BA)[l * GW + 64 * j + 16 * qtr + (lane & 15)], bx_n = INP(I_BX)[l * GW + 64 * j + 16 * qtr + (lane & 15)];
    const int c = tid & 15, seg = tid >> 4, ch = 64 * j + 16 * qtr + c;
    const float lamv = INP(I_LAMBDA)[l * GW + ch];
    const float kc = -8.f * log1pf(expf(-lamv));
    LAS float* carry = (LAS float*)(F.lds + CARRY);
    if (tid < 16) carry[tid] = 0.f;
    for (int ck = 0; ck < SEQ / TC; ++ck) {
        const int t0 = ck * TC;
        for (int idx = tid; idx < 259 * 8; idx += NTHREADS) { const int r = idx >> 3, c8 = idx & 7, t = t0 - 3 + r; u32x4 v = {0u, 0u, 0u, 0u};
            if (t >= 0) v = *(const u32x4*)(U + (size_t)(tok0 + t) * DIN + 64 * j + 8 * c8);
            *(LAS u32x4*)(F.lds + XRAW + r * 128 + c8 * 16) = v; }
        __syncthreads();
#pragma unroll
        for (int i = 0; i < 4; ++i) { const int t = trow + 64 * i; float xc[8];
#pragma unroll
            for (int k = 0; k < 8; ++k) xc[k] = cb[k];
#pragma unroll
            for (int w = 0; w < 4; ++w) { const u32x4 v = *(const LAS u32x4*)(F.lds + XRAW + (t + w) * 128 + cc * 16);
#pragma unroll
                for (int k = 0; k < 4; ++k) { xc[2 * k] += cw[w][2 * k] * bf_lo(v[k]); xc[2 * k + 1] += cw[w][2 * k + 1] * bf_hi(v[k]); } }
            u32x4 o; o.x = cvt_pk(xc[0], xc[1]); o.y = cvt_pk(xc[2], xc[3]); o.z = cvt_pk(xc[4], xc[5]); o.w = cvt_pk(xc[6], xc[7]);
            *(LAS u32x4*)(F.lds + XC + t * XCP + cc * 16) = o; }
        __syncthreads();
#pragma unroll
        for (int r2 = 0; r2 < 2; ++r2) { const int rt = 2 * wave + r2; f32x4 aa = {0.f, 0.f, 0.f, 0.f}, ax = {0.f, 0.f, 0.f, 0.f};
#pragma unroll
            for (int ks = 0; ks < 2; ++ks) { const bf16x8 af = *(const LAS bf16x8*)(F.lds + XC + (16 * rt + (lane & 15)) * XCP + (32 * ks + 8 * (lane >> 4)) * 2);
                aa = __builtin_amdgcn_mfma_f32_16x16x32_bf16(af, bA[ks], aa, 0, 0, 0); ax = __builtin_amdgcn_mfma_f32_16x16x32_bf16(af, bX[ks], ax, 0, 0, 0); }
#pragma unroll
            for (int r = 0; r < 4; ++r) { const int t = 16 * rt + 4 * (lane >> 4) + r;
                ((LAS float*)(F.lds + GR))[t * 16 + (lane & 15)] = sigmoidf_(aa[r] + ba_n); ((LAS float*)(F.lds + GI))[t * 16 + (lane & 15)] = sigmoidf_(ax[r] + bx_n); } }
        __syncthreads();
        float av[8], bv[8], A = 1.f, Bv = 0.f;
#pragma unroll
        for (int k = 0; k < 8; ++k) { const int t = 8 * seg + k;
            const float r = ((const LAS float*)(F.lds + GR))[t * 16 + c], ig = ((const LAS float*)(F.lds + GI))[t * 16 + c];
            const float xcv = bf1(*(const LAS bf16_t*)(F.lds + XC + t * XCP + (16 * qtr + c) * 2));
            const float la = r * kc; av[k] = fast_exp2(la * LOG2E); bv[k] = sqrtf(-expm1f(2.f * la)) * (ig * xcv);
            A *= av[k]; Bv = av[k] * Bv + bv[k]; }
        ((LAS float*)(F.lds + SEGA))[seg * 16 + c] = A; ((LAS float*)(F.lds + SEGB))[seg * 16 + c] = Bv;
        __syncthreads();
        float hcur = carry[c];
        for (int s2 = 0; s2 < seg; ++s2) hcur = ((const LAS float*)(F.lds + SEGA))[s2 * 16 + c] * hcur + ((const LAS float*)(F.lds + SEGB))[s2 * 16 + c];
#pragma unroll
        for (int k = 0; k < 8; ++k) { const int t = t0 + 8 * seg + k; hcur = av[k] * hcur + bv[k];
            const float g = bf1(U[(size_t)(tok0 + t) * DIN + 512 + ch]);
            const float z = 1.5957691216057308f * (g + 0.044715f * g * g * g);
            const float yv = hcur * g * sigmoidf_(z);
            Y[(size_t)(tok0 + t) * DMIX + ch] = (bf16_t)(cvt_pk(yv, 0.f) & 0xffffu); }
        __syncthreads();
        if (seg == 31) carry[c] = hcur;
    }
    __syncthreads();
}
}

__device__ __forceinline__ void p2_mixer(Ctx& F, int l) {
    if (F.tid < 64) F.tf[TF_GQ + F.tid] = INP(I_DQG)[l * 64 + F.tid];
    if (F.tid < 128) { F.tf[TF_DHG + F.tid] = INP(I_DHG)[l * 128 + F.tid]; F.tf[TF_MQG + F.tid] = INP(I_MQG)[l * 128 + F.tid]; F.tf[TF_MKG + F.tid] = INP(I_MKG)[l * 128 + F.tid]; }
    if (F.wave == 0) {
        const int ln = F.lane; const float lam_init = (l == 0) ? 0.2f : 0.35550907f;
        const float s1 = wave_sum(INP(I_LQ1)[l * 64 + ln] * INP(I_LK1)[l * 64 + ln]), s2 = wave_sum(INP(I_LQ2)[l * 64 + ln] * INP(I_LK2)[l * 64 + ln]);
        const float mq = wave_max(fabsf(INP(I_DQG)[l * 64 + ln])), mk = wave_max(fabsf(INP(I_DKG)[l * 64 + ln]));
        const float mmq = wave_max(fmaxf(fabsf(INP(I_MQG)[l * 128 + ln]), fabsf(INP(I_MQG)[l * 128 + 64 + ln]))), mmk = wave_max(fmaxf(fabsf(INP(I_MKG)[l * 128 + ln]), fabsf(INP(I_MKG)[l * 128 + 64 + ln])));
        if (ln == 0) { F.tf[TF_SC + 0] = expf(s1) - expf(s2) + lam_init; F.tf[TF_SC + 1] = 8.f * mq * mk * LOG2E; F.tf[TF_SC + 2] = 11.313708498984761f * mmq * mmk * LOG2E; }
    }
    __syncthreads();
    if (KIND(2)) for (int u = F.vcu; u < 256; u += F.G) lru::unit(F, l, u >> 5, (u >> 2) & 7, u & 3);
    if (KIND(3)) for (int dp = F.vcu; dp < 512; dp += F.G) {
        const int x = (dp & 255) >> 5, w = dp & 31, pu = w + 32 * (dp >> 8), bh = x + 8 * (pu >> 4), pr = pu & 15;
        att::diff_unit(F, l, bh >> 2, bh & 3, 31 - pr);
        att::diff_unit(F, l, bh >> 2, bh & 3, pr);
    }
    if (KIND(4)) for (int mu = F.vcu; mu < 512; mu += F.G) { const int bh = mu >> 4; att::mem_unit(F, l, bh >> 2, bh & 3, mu & 15); }
}

__device__ __forceinline__ void p4_router(Ctx& F, int l) {
    const int lane = F.lane, wave = F.wave, tid = F.tid;
    const float* X = F.out; bf16_t* XB = (bf16_t*)(F.ws + WS_XB); const float* Wr = (const float*)(F.ws + WS_WR) + (size_t)l * 48 * D;
    float* rstd2 = (float*)(F.ws + WS_RSTD2); unsigned* route = (unsigned*)(F.ws + WS_ROUTE); unsigned* gcnt = (unsigned*)(F.ws + WS_CTL) + CW_GCNT + 64 * l;
    LAS float* lg = (LAS float*)(F.lds) + wave * (16 * 48 + 16); LAS float* rsl = lg + 16 * 48;
    LAS int* hist = F.ti + TI_HIST; LAS int* base = F.ti + TI_BASE;
    for (int it = blockIdx.x; it < T / 128; it += F.G) {
        if (tid < NEXP) hist[tid] = 0;
        __syncthreads();
        const int row = it * 128 + wave * 16 + (lane & 15), kq = lane >> 4;
        const float* xr = X + (size_t)row * D + 4 * kq; const float* w0 = Wr + (size_t)(lane & 15) * D + 4 * kq;
        bf16_t* xo = XB + (size_t)row * D + 4 * kq;
        f32x4 a0 = {0.f, 0.f, 0.f, 0.f}, a1 = a0, a2 = a0; float ss = 0.f;
#pragma unroll 4
        for (int i = 0; i < 64; ++i) {
            const f32x4 a = *(const f32x4*)(xr + 16 * i), b0 = *(const f32x4*)(w0 + 16 * i), b1 = *(const f32x4*)(w0 + 16 * D + 16 * i), b2 = *(const f32x4*)(w0 + 32 * D + 16 * i);
            ss += (a[0] * a[0] + a[1] * a[1]) + (a[2] * a[2] + a[3] * a[3]);
            u32x2 w; w.x = cvt_pk(a[0], a[1]); w.y = cvt_pk(a[2], a[3]); *(u32x2*)(xo + 16 * i) = w;
#pragma unroll
            for (int e = 0; e < 4; ++e) { a0 = __builtin_amdgcn_mfma_f32_16x16x4f32(a[e], b0[e], a0, 0, 0, 0); a1 = __builtin_amdgcn_mfma_f32_16x16x4f32(a[e], b1[e], a1, 0, 0, 0); a2 = __builtin_amdgcn_mfma_f32_16x16x4f32(a[e], b2[e], a2, 0, 0, 0); }
        }
        ss += xswz<16>(ss); ss = xhalf_sum(ss);
        const float rs = __builtin_amdgcn_rsqf(ss * (1.f / D) + EPS);
        if (lane < 16) rsl[lane] = rs;
        LDS_WAIT(); asm volatile("" ::: "memory");
#pragma unroll
        for (int r = 0; r < 4; ++r) { const int rr = 4 * kq + r; const float rsr = rsl[rr];
            lg[rr * 48 + (lane & 15)] = a0[r] * rsr; lg[rr * 48 + 16 + (lane & 15)] = a1[r] * rsr; lg[rr * 48 + 32 + (lane & 15)] = a2[r] * rsr; }
        LDS_WAIT(); asm volatile("" ::: "memory");
        int e0 = 0, e1 = 0, lp0 = 0, lp1 = 0; float cw0 = 0.f, cw1 = 0.f;
        if (lane < 16) {
            const LAS float* L = lg + lane * 48; const float* brg = INP(I_BRG) + l * 4; const float* bre = INP(I_BRE) + l * NEXP;
            float g0 = L[0] + brg[0]; int gi = 0; float gl[4]; gl[0] = g0;
#pragma unroll
            for (int k = 1; k < 4; ++k) { gl[k] = L[k] + brg[k]; if (gl[k] > g0) { g0 = gl[k]; gi = k; } }
            float den = 0.f;
#pragma unroll
            for (int k = 0; k < 4; ++k) den += expf(gl[k] - g0);
            const float gate = 1.f / den;
            float le[8];
#pragma unroll
            for (int k = 0; k < 8; ++k) le[k] = L[4 + 8 * gi + k] + bre[8 * gi + k];
            float m0 = le[0]; int i0 = 0;
#pragma unroll
            for (int k = 1; k < 8; ++k) if (le[k] > m0) { m0 = le[k]; i0 = k; }
            float m1 = -INFINITY; int i1 = 0;
#pragma unroll
            for (int k = 0; k < 8; ++k) if (k != i0 && le[k] > m1) { m1 = le[k]; i1 = k; }
            const float ex = expf(m1 - m0), w0v = 1.f / (1.f + ex);
            cw0 = gate * w0v; cw1 = gate * (ex * w0v); e0 = 8 * gi + i0; e1 = 8 * gi + i1;
            lp0 = __hip_atomic_fetch_add(hist + e0, 1, __ATOMIC_RELAXED, __HIP_MEMORY_SCOPE_WORKGROUP);
            lp1 = __hip_atomic_fetch_add(hist + e1, 1, __ATOMIC_RELAXED, __HIP_MEMORY_SCOPE_WORKGROUP);
        }
        __syncthreads();
        if (tid < NEXP) base[tid] = (int)__hip_atomic_fetch_add(gcnt + tid, (unsigned)hist[tid], __ATOMIC_RELAXED, __HIP_MEMORY_SCOPE_AGENT);
        __syncthreads();
        if (lane < 16) { u32x4 r0, r1; r0.x = (unsigned)e0; r0.y = (unsigned)(base[e0] + lp0); r0.z = (unsigned)e1; r0.w = (unsigned)(base[e1] + lp1);
            r1.x = __float_as_uint(cw0); r1.y = __float_as_uint(cw1); r1.z = __float_as_uint(rs); r1.w = 0u;
            *(u32x4*)(route + (size_t)row * 8) = r0; *(u32x4*)(route + (size_t)row * 8 + 4) = r1; rstd2[row] = rs; }
        __syncthreads();
    }
}
__device__ __forceinline__ void moe_tables(Ctx& F, int l) {
    const unsigned* gcnt = (const unsigned*)(F.ws + WS_CTL) + CW_GCNT + 64 * l;
    if (F.tid < NEXP) F.ti[TI_CNT + F.tid] = (int)__hip_atomic_load(gcnt + F.tid, __ATOMIC_RELAXED, __HIP_MEMORY_SCOPE_AGENT);
    __syncthreads();
    if (F.tid == 0) { int o = 0, t = 0; for (int e = 0; e < NEXP; ++e) { F.ti[TI_OFF + e] = o; F.ti[TI_TS + e] = t; const int c = F.ti[TI_CNT + e]; o += c; t += (c + 255) >> 8; } F.ti[TI_OFF + NEXP] = o; F.ti[TI_TS + NEXP] = t; }
    __syncthreads();
}
__device__ __forceinline__ void p5_gather(Ctx& F, int l) {
    moe_tables(F, l);
    const int gw = F.vcu * NWAVES + F.wave, NGW = F.G * NWAVES, lane = F.lane;
    const bf16_t* XB = (const bf16_t*)(F.ws + WS_XB); bf16_t* XG = (bf16_t*)(F.ws + WS_XG); const unsigned* route = (const unsigned*)(F.ws + WS_ROUTE);
    float* pr = (float*)(F.ws + WS_PAIRR); float* pw = (float*)(F.ws + WS_PAIRW); int* tokpair = (int*)(F.ws + WS_TOKPAIR);
    for (int m = gw; m < T; m += NGW) {
        const u32x4 r0 = *(const u32x4*)(route + (size_t)m * 8), r1 = *(const u32x4*)(route + (size_t)m * 8 + 4);
        const int p0 = F.ti[TI_OFF + (int)r0.x] + (int)r0.y, p1 = F.ti[TI_OFF + (int)r0.z] + (int)r0.w;
        const u32x4* src = (const u32x4*)(XB + (size_t)m * D) + lane; const u32x4 v0 = src[0], v1 = src[64];
        u32x4* d0 = (u32x4*)(XG + (size_t)p0 * D) + lane; u32x4* d1 = (u32x4*)(XG + (size_t)p1 * D) + lane;
        d0[0] = v0; d0[64] = v1; d1[0] = v0; d1[64] = v1;
        if (lane == 0) { pr[p0] = __uint_as_float(r1.z); pw[p0] = __uint_as_float(r1.x); pr[p1] = __uint_as_float(r1.z); pw[p1] = __uint_as_float(r1.y); tokpair[2 * m] = p0; tokpair[2 * m + 1] = p1; }
    }
}
__device__ __forceinline__ void p8_combine(Ctx& F, int l) {
    const int gw = F.vcu * NWAVES + F.wave, NGW = F.G * NWAVES, lane = F.lane;
    float* X = F.out; const bf16_t* YP = (const bf16_t*)(F.ws + WS_YP); const int* tokpair = (const int*)(F.ws + WS_TOKPAIR);
    bf16_t* XB = (bf16_t*)(F.ws + WS_XB); float* rstdx = (float*)(F.ws + WS_RSTDX);
    for (int m = gw; m < T; m += NGW) {
        const int p0 = tokpair[2 * m], p1 = tokpair[2 * m + 1];
        f32x4* xr = (f32x4*)(X + (size_t)m * D) + lane; const u32x2* y0 = (const u32x2*)(YP + (size_t)p0 * D) + lane; const u32x2* y1 = (const u32x2*)(YP + (size_t)p1 * D) + lane;
        f32x4 v[4]; float s = 0.f;
#pragma unroll
        for (int j = 0; j < 4; ++j) { const f32x4 x = xr[64 * j]; const u32x2 a = y0[64 * j], b = y1[64 * j];
            v[j].x = x.x + bf_lo(a.x) + bf_lo(b.x); v[j].y = x.y + bf_hi(a.x) + bf_hi(b.x); v[j].z = x.z + bf_lo(a.y) + bf_lo(b.y); v[j].w = x.w + bf_hi(a.y) + bf_hi(b.y);
            xr[64 * j] = v[j]; s += (v[j].x * v[j].x + v[j].y * v[j].y) + (v[j].z * v[j].z + v[j].w * v[j].w); }
        if (l + 1 < DEPTH) {
            s = wave_sum(s);
            u32x2* o8 = (u32x2*)(XB + (size_t)m * D) + lane;
#pragma unroll
            for (int j = 0; j < 4; ++j) { u32x2 w; w.x = cvt_pk(v[j].x, v[j].y); w.y = cvt_pk(v[j].z, v[j].w); o8[64 * j] = w; }
            if (lane == 0) rstdx[m] = __builtin_amdgcn_rsqf(s * (1.f / D) + EPS);
        }
    }
}

#ifndef MK_N_LAUNCHES
#define MK_N_LAUNCHES 1
#endif
constexpr int NPH = 1 + 8 * DEPTH;
struct Args { const float* in[31]; float* out; unsigned char* ws; int ph_lo, ph_hi; };
__global__ void __launch_bounds__(NTHREADS, 2) hymba_fwd(Args args) {
    extern __shared__ __attribute__((aligned(16))) unsigned char lds[];
    Ctx F;
    F.lds = (LAS unsigned char*)lds; F.ti = (LAS int*)(F.lds + TAB_OFF); F.tf = (LAS float*)(F.lds + TAB_OFF);
    F.tid = threadIdx.x; F.lane = F.tid & 63; F.wave = __builtin_amdgcn_readfirstlane(F.tid >> 6);
    F.G = gridDim.x; { const int bx = blockIdx.x; F.vcu = (F.G % 8 == 0) ? (bx % 8) * (F.G / 8) + bx / 8 : bx; }
    F.out = args.out; F.ws = args.ws;
    volatile LAS unsigned* MISC = (volatile LAS unsigned*)(F.lds + MISC_OFF);
    if (F.tid < 32) MISC[F.tid] = 0u;
    __syncthreads();
    XcdBarrier bar; bar.bar = (unsigned*)(F.ws + WS_CTL) + CW_BAR; bar.x = 0; bar.st = nullptr;
    if (MK_N_LAUNCHES == 1) bar = xcd_barrier_post((unsigned*)(F.ws + WS_CTL) + CW_BAR, MISC + 8);
    const int lo = args.ph_lo, hi = args.ph_hi;
#define IN(k) (lo <= (k) && (k) < hi)
#define SEAM(k) do { if (IN(k) && IN((k) + 1)) xcd_barrier(bar); asm volatile("" : "+v"(F.tid)); F.lane = F.tid & 63; F.wave = __builtin_amdgcn_readfirstlane(F.tid >> 6); } while (0)
    if (KIND(0) && IN(0)) { p0_prologue(F); } SEAM(0);
#pragma unroll 1
    for (int l = 0; l < DEPTH; ++l) {
        const int pb = 1 + 8 * l;
        if (KIND(1) && IN(pb + 0)) {
            { pg8::DenseOrder S; S.init((const bf16_t*)(F.ws + WS_XB), (const bf16_t*)(F.ws + WS_WIN) + (size_t)l * DIN * D, T, DIN, D, F.G, (int)blockIdx.x);
              pg8::EpiIn E{(bf16_t*)(F.ws + WS_U), DIN, (const float*)(F.ws + WS_RSTDX), INP(I_DKG) + l * 64, 1536, 2048};
              pg8::gemm_phase<pg8::EpiIn, pg8::DenseOrder, true, true>(F.lds, D, S, E); }
            if (l == 0) { pg8::DenseOrder S; S.init((const bf16_t*)(F.ws + WS_MEMB), (const bf16_t*)(F.ws + WS_WKV), TM, 2048, D, F.G, (int)blockIdx.x);
              pg8::EpiIn E{(bf16_t*)(F.ws + WS_KVB), 2048, (const float*)(F.ws + WS_RSTDM), nullptr, 0, 0};
              pg8::gemm_phase<pg8::EpiIn, pg8::DenseOrder, true, true>(F.lds, D, S, E); }
        } SEAM(pb + 0);
        if ((KIND(2) || KIND(3) || KIND(4)) && IN(pb + 1)) { p2_mixer(F, l); } SEAM(pb + 1);
        if (KIND(5) && IN(pb + 2)) {
            pg8::DenseOrder S; S.init((const bf16_t*)(F.ws + WS_Y), (const bf16_t*)(F.ws + WS_WOUT) + (size_t)l * D * DMIX, T, D, DMIX, F.G, (int)blockIdx.x);
            pg8::EpiOutRes E{l == 0 ? INP(I_X) : F.out, F.out, D};
            pg8::gemm_phase<pg8::EpiOutRes, pg8::DenseOrder, true, true>(F.lds, DMIX, S, E);
        } SEAM(pb + 2);
        if (KIND(6) && IN(pb + 3)) { p4_router(F, l); } SEAM(pb + 3);
        if (KIND(7) && IN(pb + 4)) { p5_gather(F, l); } SEAM(pb + 4);
        if (KIND(8) && IN(pb + 5)) {
            moe_tables(F, l);
            pg8::MoeOrder S{F.ti + TI_CNT, F.ti + TI_OFF, F.ti + TI_TS, (const char*)(F.ws + WS_XG), (const char*)((const bf16_t*)(F.ws + WS_WGU) + (size_t)l * NEXP * 512 * D), D, 2, 512, 128, F.G, (int)blockIdx.x};
            pg8::EpiMoe1 E{(bf16_t*)(F.ws + WS_H), (const float*)(F.ws + WS_PAIRR), (const float*)(F.ws + WS_PAIRW)};
            pg8::gemm_phase<pg8::EpiMoe1, pg8::MoeOrder, true, true>(F.lds, D, S, E);
        } SEAM(pb + 5);
        if (KIND(9) && IN(pb + 6)) {
            moe_tables(F, l);
            pg8::MoeOrder S{F.ti + TI_CNT, F.ti + TI_OFF, F.ti + TI_TS, (const char*)(F.ws + WS_H), (const char*)((const bf16_t*)(F.ws + WS_WD) + (size_t)l * NEXP * D * DEXP), DEXP, 4, 1024, 256, F.G, (int)blockIdx.x};
            pg8::EpiMoe2 E{(bf16_t*)(F.ws + WS_YP)};
            pg8::gemm_phase<pg8::EpiMoe2, pg8::MoeOrder, true, true>(F.lds, DEXP, S, E);
        } SEAM(pb + 6);
        if (KIND(10) && IN(pb + 7)) { p8_combine(F, l); } SEAM(pb + 7);
    }
#undef IN
#undef SEAM
}

extern "C" void kernel_launch(void* const* d_in, const int* in_sizes, int n_in, void* d_out, int out_size, void* d_ws, size_t ws_size, hipStream_t stream) {
    static int grid = 0;
    if (grid == 0) {
        if (n_in != 31 || in_sizes[0] != T * D || out_size != T * D || ws_size < WS_END) { fprintf(stderr, "kernel_launch: unexpected shapes (n_in %d, in0 %d, out %d, ws %zu)\n", n_in, n_in > 0 ? in_sizes[0] : -1, out_size, ws_size); grid = -1; return; }
        int dev = 0, cus = 0, per_cu = 0;
        if (hipGetDevice(&dev) != hipSuccess || hipDeviceGetAttribute(&cus, hipDeviceAttributeMultiprocessorCount, dev) != hipSuccess) { grid = -1; return; }
        if (hipFuncSetAttribute((const void*)hymba_fwd, hipFuncAttributeMaxDynamicSharedMemorySize, LDS_BYTES) != hipSuccess) { fprintf(stderr, "kernel_launch: hipFuncSetAttribute failed\n"); grid = -1; return; }
        if (hipOccupancyMaxActiveBlocksPerMultiprocessor(&per_cu, (const void*)hymba_fwd, NTHREADS, LDS_BYTES) != hipSuccess || per_cu < 1) fprintf(stderr, "kernel_launch: occupancy query reports %d workgroups per CU\n", per_cu);
        (void)hipGetLastError();
        grid = cus;
    }
    if (grid < 0) return;
    if (hipMemsetAsync((char*)d_ws + WS_CTL, 0, CTL_ZERO_BYTES, stream) != hipSuccess) return;
    Args a{};
    for (int i = 0; i < 31; ++i) a.in[i] = (const float*)d_in[i];
    a.out = (float*)d_out; a.ws = (unsigned char*)d_ws;
    if (MK_N_LAUNCHES == 1) { a.ph_lo = 0; a.ph_hi = NPH; hipLaunchKernelGGL(hymba_fwd, dim3(grid), dim3(NTHREADS), LDS_BYTES, stream, a); }
    else for (int p = 0; p < NPH; ++p) { a.ph_lo = p; a.ph_hi = p + 1; hipLaunchKernelGGL(hymba_fwd, dim3(grid), dim3(NTHREADS), LDS_BYTES, stream, a); }
}
```

```cpp
#include <hip/hip_runtime.h>
#include <cstdio>
#include <cstdint>

#ifndef KIND_MASK
#define KIND_MASK 0x7ff
#endif
#define KIND(k) (((KIND_MASK) >> (k)) & 1)
#ifndef DUP_MASK
#define DUP_MASK 0
#endif
#define NREP(k) (1 + (((DUP_MASK) >> (k)) & 1))
#define LAS __attribute__((address_space(3)))
#define GAS __attribute__((address_space(1)))
typedef unsigned short bf16_t;
typedef short bf16x8 __attribute__((ext_vector_type(8)));
typedef short s16x4 __attribute__((ext_vector_type(4)));
typedef float f32x4 __attribute__((ext_vector_type(4)));
typedef float f32x16 __attribute__((ext_vector_type(16)));
typedef float f32x2 __attribute__((ext_vector_type(2)));
typedef unsigned u32x4 __attribute__((ext_vector_type(4)));
typedef unsigned u32x2 __attribute__((ext_vector_type(2)));
typedef __bf16 bf16x2_t __attribute__((ext_vector_type(2)));

constexpr int BATCH = 8, SEQ = 4096, T = BATCH * SEQ, D = 1024, DIN = 3072, GW = 512, DMIX = 1536, MEML = 256, TM = BATCH * MEML;
constexpr int NEXP = 32, DEXP = 256, NPAIR = 2 * T, DEPTH = 2;
constexpr float EPS = 1e-6f, LOG2E = 1.4426950408889634f;
constexpr int NWAVES = 8, NTHREADS = 512;

__device__ __forceinline__ unsigned cvt_pk(float lo, float hi) { f32x2 v = {lo, hi}; bf16x2_t b = __builtin_convertvector(v, bf16x2_t); return __builtin_bit_cast(unsigned, b); }
__device__ __forceinline__ float bf_lo(unsigned w) { return __uint_as_float(w << 16); }
__device__ __forceinline__ float bf_hi(unsigned w) { return __uint_as_float(w & 0xffff0000u); }
__device__ __forceinline__ float bf1(bf16_t w) { return __uint_as_float((unsigned)w << 16); }
template <int K> __device__ __forceinline__ float xswz(float v) { return __int_as_float(__builtin_amdgcn_ds_swizzle(__float_as_int(v), 0x1f | (K << 10))); }
__device__ __forceinline__ float xhalf(float v) { const unsigned u = __float_as_uint(v); auto rr = __builtin_amdgcn_permlane32_swap(u, u, false, false); const unsigned me = rr[0], ot = rr[1]; return __uint_as_float(me == u ? ot : me); }
__device__ __forceinline__ float xhalf_sum(float v) { const unsigned u = __float_as_uint(v); auto rr = __builtin_amdgcn_permlane32_swap(u, u, false, false); return __uint_as_float(rr[0]) + __uint_as_float(rr[1]); }
__device__ __forceinline__ float xhalf_max(float v) { const unsigned u = __float_as_uint(v); auto rr = __builtin_amdgcn_permlane32_swap(u, u, false, false); return fmaxf(__uint_as_float(rr[0]), __uint_as_float(rr[1])); }
__device__ __forceinline__ float fast_exp2(float x) { return __builtin_amdgcn_exp2f(x); }
__device__ __forceinline__ float fast_rcp(float x) { return __builtin_amdgcn_rcpf(x); }
__device__ __forceinline__ float sigmoidf_(float x) { return fast_rcp(1.f + fast_exp2(-x * LOG2E)); }

namespace pg8 {
#define PG8_LAS __attribute__((address_space(3)))
constexpr int BM = 256, BK = 64, HALF = 128, HTB = HALF * BK * 2, STAGE_BYTES = 8 * HTB, NXCD = 8, WGM = 8;
__host__ __device__ __forceinline__ int lds_byte(int r, int c) { const int st = (r >> 4) * 2 + (c >> 5), rr = r & 15, cc = c & 31, ob = rr * 64 + cc * 2; return st * 1024 + (ob ^ (((ob >> 9) & 1) << 5)); }
__host__ __device__ __forceinline__ void stage_rc(int b, int& R, int& C) { const int st = b / 1024, sb = b % 1024, swz = sb ^ (((sb >> 9) & 1) << 5); R = (st >> 1) * 16 + swz / 64; C = (st & 1) * 32 + (swz % 64) / 2; }
__host__ __device__ __forceinline__ int perm32(int rho) { const int n = rho >> 4, i = rho & 15; return 8 * (i >> 2) + 4 * n + (i & 3); }

struct Unit { const char* a; const char* b; int row0, col0, rows, aux; };

struct StaticOrder {
    int nM, nN, nwg, G, c;
    __device__ void init(int M, int N, int G_, int c_) { nM = M / BM; nN = N / BM; nwg = nM * nN; G = G_; c = c_; }
    __device__ bool next(int i, int& pm, int& pn) const {
        const long L = (long)i * G + c; if (L >= nwg) return false;
        int wgid = (int)L; { const int q = nwg / NXCD, r = nwg % NXCD, xcd = wgid % NXCD, off = wgid / NXCD; wgid = (xcd < r ? xcd * (q + 1) : r * (q + 1) + (xcd - r) * q) + off; }
        const int nig = WGM * nN, gid = wgid / nig, fm = gid * WGM, gsz = (nM - fm) < WGM ? (nM - fm) : WGM;
        pm = fm + ((wgid % nig) % gsz); pn = (wgid % nig) / gsz; return true;
    }
};
struct DenseOrder {
    StaticOrder so; const char* A; const char* Bt; size_t tstep;
    __device__ void init(const bf16_t* A_, const bf16_t* Bt_, int M, int N, int K, int G, int c) { so.init(M, N, G, c); A = (const char*)A_; Bt = (const char*)Bt_; tstep = (size_t)BM * K * 2; }
    __device__ __forceinline__ bool next(int i, Unit& u) const { int pm, pn; if (!so.next(i, pm, pn)) return false; u.a = A + (size_t)pm * tstep; u.b = Bt + (size_t)pn * tstep; u.row0 = pm * BM; u.col0 = pn * BM; u.rows = BM; u.aux = 0; return true; }
    __device__ __forceinline__ void a_ready(const Unit&) const {}
    __device__ __forceinline__ void done(const Unit&) const {}
};
struct MoeOrder {
    const LAS int* cnt; const LAS int* off; const LAS int* ts; const char* A; const char* Bt; int K, NCT, NB, colw, G, c;
    __device__ __forceinline__ bool next(int i, Unit& u) const {
        const int R = __builtin_amdgcn_readfirstlane(ts[NEXP]);
        const long L = (long)i * G + c; if (L >= (long)R * NCT) return false;
        const int rt = (int)(L / NCT), ct = (int)(L % NCT);
        int e = 0;
        for (; e < NEXP - 1; ++e) if (rt < __builtin_amdgcn_readfirstlane(ts[e + 1])) break;
        const int rl = rt - __builtin_amdgcn_readfirstlane(ts[e]);
        const int row0 = __builtin_amdgcn_readfirstlane(off[e]) + BM * rl;
        const int left = __builtin_amdgcn_readfirstlane(cnt[e]) - BM * rl;
        u.a = A + (size_t)row0 * K * 2; u.b = Bt + ((size_t)e * NB + (size_t)ct * BM) * K * 2; u.row0 = row0; u.col0 = ct * colw; u.rows = left < BM ? left : BM; u.aux = e; return true;
    }
    __device__ __forceinline__ void a_ready(const Unit&) const {}
    __device__ __forceinline__ void done(const Unit&) const {}
};


struct EpiIn {
    static constexpr bool PERM = true, AFTER_DRAIN = false;
    bf16_t* O; int ldc; const float* rstd; const float* hg; int hn_lo, hn_hi;
    __device__ __forceinline__ void operator()(const f32x4 (&acc)[2][2][4][2], const Unit& u, int wr, int wc, int fr, int fq) const {
        const int row0 = u.row0 + wr * 64 + fr;
        if (u.col0 >= hn_lo && u.col0 < hn_hi) {
            int fqo = fq; asm volatile("" : "+v"(fqo));
            const float* hgp = hg + 8 * fqo;
#pragma unroll
            for (int ai = 0; ai < 2; ++ai)
#pragma unroll
                for (int m = 0; m < 4; ++m) {
                    const int row = row0 + ai * HALF + m * 16; const float rs = rstd[row];
                    float ss = 0.f;
#pragma unroll
                    for (int bj = 0; bj < 2; ++bj)
#pragma unroll
                        for (int n = 0; n < 2; ++n) { const f32x4 a = acc[ai][bj][m][n]; ss += (a[0] * a[0] + a[1] * a[1]) + (a[2] * a[2] + a[3] * a[3]); }
                    ss += xswz<16>(ss); ss = xhalf_sum(ss);
                    const float sc = rs * __builtin_amdgcn_rsqf(ss * rs * rs * (1.f / 64.f) + EPS);
                    const unsigned off = (unsigned)row * (unsigned)ldc + (unsigned)(u.col0 + 64 * wc + 8 * fq);
#pragma unroll
                    for (int bj = 0; bj < 2; ++bj) { const f32x4 g0 = *(const f32x4*)(hgp + 32 * bj), g1 = *(const f32x4*)(hgp + 32 * bj + 4);
                        const f32x4 a0 = acc[ai][bj][m][0] * sc * g0, a1 = acc[ai][bj][m][1] * sc * g1;
                        u32x4 w; w.x = cvt_pk(a0[0], a0[1]); w.y = cvt_pk(a0[2], a0[3]); w.z = cvt_pk(a1[0], a1[1]); w.w = cvt_pk(a1[2], a1[3]);
                        *(u32x4*)(O + off + 32 * bj) = w; }
                }
        } else {
#pragma unroll
            for (int ai = 0; ai < 2; ++ai)
#pragma unroll
                for (int m = 0; m < 4; ++m) {
                    const int row = row0 + ai * HALF + m * 16; const float rs = rstd[row];
                    const unsigned off = (unsigned)row * (unsigned)ldc + (unsigned)(u.col0 + 32 * wc + 8 * fq);
#pragma unroll
                    for (int bj = 0; bj < 2; ++bj) { const f32x4 a0 = acc[ai][bj][m][0] * rs, a1 = acc[ai][bj][m][1] * rs;
                        u32x4 w; w.x = cvt_pk(a0[0], a0[1]); w.y = cvt_pk(a0[2], a0[3]); w.z = cvt_pk(a1[0], a1[1]); w.w = cvt_pk(a1[2], a1[3]);
                        *(u32x4*)(O + off + bj * HALF) = w; }
                }
        }
    }
};
struct EpiOutRes {
    static constexpr bool PERM = false, AFTER_DRAIN = false;
    const float* base; float* out; int ldc;
    __device__ __forceinline__ void operator()(const f32x4 (&acc)[2][2][4][2], const Unit& u, int wr, int wc, int fr, int fq) const {
        const int row0 = u.row0 + wr * 64 + fr, col0 = u.col0 + wc * 32 + 4 * fq;
#pragma unroll
        for (int ai = 0; ai < 2; ++ai)
#pragma unroll
            for (int m = 0; m < 4; ++m) { const size_t off = (size_t)(row0 + ai * HALF + m * 16) * ldc + col0;
#pragma unroll
                for (int bj = 0; bj < 2; ++bj)
#pragma unroll
                    for (int n = 0; n < 2; ++n) { const f32x4 bs = *(const f32x4*)(base + off + bj * HALF + n * 16); *(f32x4*)(out + off + bj * HALF + n * 16) = bs + acc[ai][bj][m][n]; } }
    }
};
struct EpiMoe1 {
    static constexpr bool PERM = true, AFTER_DRAIN = false;
    bf16_t* Hh; const float* pr; const float* pw;
    __device__ __forceinline__ void operator()(const f32x4 (&acc)[2][2][4][2], const Unit& u, int wr, int wc, int fr, int fq) const {
#pragma unroll
        for (int ai = 0; ai < 2; ++ai)
#pragma unroll
            for (int m = 0; m < 4; ++m) {
                const int rl = ai * HALF + wr * 64 + m * 16 + fr;
                if (rl < u.rows) {
                    const int p = u.row0 + rl; const float rs = pr[p], w = pw[p];
                    float hv[8];
#pragma unroll
                    for (int n = 0; n < 2; ++n)
#pragma unroll
                        for (int j = 0; j < 4; ++j) { const float g = acc[ai][0][m][n][j] * rs, up = acc[ai][1][m][n][j] * rs; hv[4 * n + j] = g * sigmoidf_(g) * up * w; }
                    u32x4 o; o.x = cvt_pk(hv[0], hv[1]); o.y = cvt_pk(hv[2], hv[3]); o.z = cvt_pk(hv[4], hv[5]); o.w = cvt_pk(hv[6], hv[7]);
                    *(u32x4*)(Hh + (size_t)p * DEXP + u.col0 + 32 * wc + 8 * fq) = o;
                }
            }
    }
};
struct EpiMoe2 {
    static constexpr bool PERM = true, AFTER_DRAIN = false;
    bf16_t* YP;
    __device__ __forceinline__ void operator()(const f32x4 (&acc)[2][2][4][2], const Unit& u, int wr, int wc, int fr, int fq) const {
#pragma unroll
        for (int ai = 0; ai < 2; ++ai)
#pragma unroll
            for (int m = 0; m < 4; ++m) {
                const int rl = ai * HALF + wr * 64 + m * 16 + fr;
                if (rl < u.rows) {
                    bf16_t* rowp = YP + (size_t)(u.row0 + rl) * D + u.col0 + 32 * wc + 8 * fq;
#pragma unroll
                    for (int bj = 0; bj < 2; ++bj) { const f32x4 a0 = acc[ai][bj][m][0], a1 = acc[ai][bj][m][1];
                        u32x4 w; w.x = cvt_pk(a0[0], a0[1]); w.y = cvt_pk(a0[2], a0[3]); w.z = cvt_pk(a1[0], a1[1]); w.w = cvt_pk(a1[2], a1[3]);
                        *(u32x4*)(rowp + bj * HALF) = w; }
                }
            }
    }
};

template <class Epi, class Sched, bool ALIGN_EPI = false, bool SP2 = false>
__device__ __forceinline__ void gemm_phase(PG8_LAS unsigned char* lds, const int K, const Sched& S, const Epi& E) {
    int tid_ = threadIdx.x; asm volatile("" : "+v"(tid_));
    const int tid = tid_, wid = __builtin_amdgcn_readfirstlane(tid >> 6), lane = tid & 63, wr = wid >> 2, wc = wid & 3, fr = lane & 15, fq = lane >> 4;
    const int nt = K / BK;
    unsigned voffA[2], voffB[2];
#pragma unroll
    for (int i = 0; i < 2; ++i) { int R, C; stage_rc(tid * 16 + i * 8192, R, C); const int Rb = Epi::PERM ? ((R & ~31) + perm32(R & 31)) : R;
        voffA[i] = (unsigned)(R * K + C) * 2u; voffB[i] = (unsigned)(Rb * K + C) * 2u; }
    const size_t kstep = (size_t)(BK * 2);
    const size_t hstep = (size_t)HALF * K * 2;
    const unsigned ldsw = (unsigned)wid * 1024u;
    const int aoff = lds_byte(wr * 64 + fr, fq * 8), boff = lds_byte(wc * 32 + fr, fq * 8);
#define PG8_SA(b, h) (((b) * 2 + (h)) * HTB)
#define PG8_SB(b, h) ((4 + (b) * 2 + (h)) * HTB)
#define PG8_STAGE(bufoff, gbase, voff) do { _Pragma("unroll") for (int _i = 0; _i < 2; ++_i) \
        __builtin_amdgcn_global_load_lds((const unsigned*)((const char*)(gbase) + (voff)[_i]), (PG8_LAS unsigned*)(lds + (bufoff) + ldsw + _i * 8192), 16, 0, 0); } while (0)
#define PG8_LDA(dst, b, h) do { _Pragma("unroll") for (int m = 0; m < 4; ++m) _Pragma("unroll") for (int k = 0; k < 2; ++k) dst[m][k] = *(const PG8_LAS bf16x8*)(lds + PG8_SA(b, h) + aoff + m * 2048 + k * 1024); } while (0)
#define PG8_LDB(dst, b, h) do { _Pragma("unroll") for (int n = 0; n < 2; ++n) _Pragma("unroll") for (int k = 0; k < 2; ++k) dst[n][k] = *(const PG8_LAS bf16x8*)(lds + PG8_SB(b, h) + boff + n * 2048 + k * 1024); } while (0)
#define PG8_MMA(ai, bj, At, Bt) do { __builtin_amdgcn_s_setprio(1); _Pragma("unroll") for (int m = 0; m < 4; ++m) _Pragma("unroll") for (int n = 0; n < 2; ++n) _Pragma("unroll") for (int k = 0; k < 2; ++k) \
        acc[ai][bj][m][n] = __builtin_amdgcn_mfma_f32_16x16x32_bf16(Bt[n][k], At[m][k], acc[ai][bj][m][n], 0, 0, 0); __builtin_amdgcn_s_setprio(0); } while (0)
#define PG8_WAIT_V(n) asm volatile("s_waitcnt vmcnt(" #n ")" ::: "memory")
#define PG8_WAIT_L(n) asm volatile("s_waitcnt lgkmcnt(" #n ")" ::: "memory")
#define PG8_BAR __builtin_amdgcn_s_barrier()
#define PG8_SCHED __builtin_amdgcn_sched_barrier(0)
    Unit cur, nxt; int ui = 0;
    if (!S.next(0, cur)) return;
    asm volatile("" : "+s"(cur.a), "+s"(cur.b));
    f32x4 acc[2][2][4][2];
#pragma unroll
    for (int a = 0; a < 2; ++a)
#pragma unroll
        for (int b = 0; b < 2; ++b)
#pragma unroll
            for (int m = 0; m < 4; ++m)
#pragma unroll
                for (int n = 0; n < 2; ++n) acc[a][b][m][n] = (f32x4){0.f, 0.f, 0.f, 0.f};
    bf16x8 At[4][2], B0[2][2], B1[2][2];
    const char* cA = cur.a; const char* cB = cur.b;
    S.a_ready(cur);
    if constexpr (SP2) {
        PG8_STAGE(PG8_SB(0, 0), cB, voffB); PG8_STAGE(PG8_SB(0, 1), cB + hstep, voffB); PG8_STAGE(PG8_SA(0, 0), cA, voffA); PG8_STAGE(PG8_SA(0, 1), cA + hstep, voffA);
        if (wr == 1) PG8_BAR;
        PG8_WAIT_V(2); PG8_BAR;
        PG8_STAGE(PG8_SB(1, 0), cB + kstep, voffB); PG8_STAGE(PG8_SA(1, 0), cA + kstep, voffA); PG8_STAGE(PG8_SB(1, 1), cB + hstep + kstep, voffB);
        PG8_WAIT_V(6); PG8_BAR;
    } else {
        PG8_STAGE(PG8_SB(0, 0), cB, voffB); PG8_STAGE(PG8_SA(0, 0), cA, voffA); PG8_STAGE(PG8_SB(0, 1), cB + hstep, voffB); PG8_STAGE(PG8_SA(0, 1), cA + hstep, voffA);
        if (wr == 1) PG8_BAR;
        PG8_WAIT_V(4); PG8_BAR;
        PG8_STAGE(PG8_SB(1, 0), cB + kstep, voffB); PG8_STAGE(PG8_SA(1, 0), cA + kstep, voffA); PG8_STAGE(PG8_SB(1, 1), cB + hstep + kstep, voffB);
        PG8_WAIT_V(6); PG8_BAR;
    }
    for (;;) {
        const bool has_next = S.next(ui + 1, nxt);
        const char* nA = has_next ? nxt.a : cA; const char* nB = has_next ? nxt.b : cB;
        for (int t = 0; t < nt; t += 2) {
            const bool last = (t == nt - 2);
            const char* a1 = cA + (size_t)(t + 1) * kstep;
            const char* a2 = last ? nA : cA + (size_t)(t + 2) * kstep; const char* b2 = last ? nB : cB + (size_t)(t + 2) * kstep;
            const char* a3 = a2 + kstep; const char* b3 = b2 + kstep;
            if (last && has_next) S.a_ready(nxt);
            if constexpr (SP2) {
            PG8_LDB(B0, 0, 0); PG8_LDB(B1, 0, 1); PG8_SCHED; PG8_LDA(At, 0, 0); PG8_STAGE(PG8_SA(1, 1), a1 + hstep, voffA);
            PG8_WAIT_V(8); PG8_WAIT_L(0); PG8_BAR; PG8_MMA(0, 0, At, B0); PG8_MMA(0, 1, At, B1); PG8_BAR; PG8_SCHED;
            PG8_LDA(At, 0, 1); PG8_STAGE(PG8_SB(0, 0), b2, voffB); PG8_STAGE(PG8_SB(0, 1), b2 + hstep, voffB); PG8_STAGE(PG8_SA(0, 0), a2, voffA);
            PG8_WAIT_V(8); PG8_WAIT_L(0); PG8_BAR; PG8_MMA(1, 0, At, B0); PG8_MMA(1, 1, At, B1); PG8_BAR; PG8_SCHED;
            PG8_LDB(B0, 1, 0); PG8_LDB(B1, 1, 1); PG8_SCHED; PG8_LDA(At, 1, 0); PG8_STAGE(PG8_SA(0, 1), a2 + hstep, voffA);
            PG8_WAIT_V(8); PG8_WAIT_L(0); PG8_BAR; PG8_MMA(0, 0, At, B0); PG8_MMA(0, 1, At, B1); PG8_BAR; PG8_SCHED;
            PG8_LDA(At, 1, 1); PG8_STAGE(PG8_SB(1, 0), b3, voffB); PG8_STAGE(PG8_SB(1, 1), b3 + hstep, voffB); PG8_STAGE(PG8_SA(1, 0), a3, voffA);
            PG8_WAIT_V(8); PG8_WAIT_L(0); PG8_BAR; PG8_MMA(1, 0, At, B0); PG8_MMA(1, 1, At, B1); PG8_BAR; PG8_SCHED;
            } else {
            PG8_LDB(B0, 0, 0); PG8_SCHED; PG8_LDA(At, 0, 0); PG8_STAGE(PG8_SA(1, 1), a1 + hstep, voffA);
            PG8_WAIT_L(8); PG8_BAR; PG8_WAIT_L(0); PG8_MMA(0, 0, At, B0); PG8_BAR; PG8_SCHED;
            PG8_LDB(B1, 0, 1); PG8_STAGE(PG8_SB(0, 0), b2, voffB);
            PG8_BAR; PG8_WAIT_L(0); PG8_MMA(0, 1, At, B1); PG8_BAR;
            PG8_LDA(At, 0, 1); PG8_STAGE(PG8_SA(0, 0), a2, voffA);
            PG8_BAR; PG8_WAIT_L(0); PG8_MMA(1, 0, At, B0); PG8_BAR; PG8_SCHED;
            PG8_STAGE(PG8_SB(0, 1), b2 + hstep, voffB);
            PG8_WAIT_V(6); PG8_BAR; PG8_MMA(1, 1, At, B1); PG8_BAR;
            PG8_LDB(B0, 1, 0); PG8_SCHED; PG8_LDA(At, 1, 0); PG8_STAGE(PG8_SA(0, 1), a2 + hstep, voffA);
            PG8_WAIT_L(8); PG8_BAR; PG8_WAIT_L(0); PG8_MMA(0, 0, At, B0); PG8_BAR; PG8_SCHED;
            PG8_LDB(B1, 1, 1); PG8_STAGE(PG8_SB(1, 0), b3, voffB);
            PG8_BAR; PG8_WAIT_L(0); PG8_MMA(0, 1, At, B1); PG8_BAR;
            PG8_LDA(At, 1, 1); PG8_STAGE(PG8_SA(1, 0), a3, voffA);
            PG8_BAR; PG8_WAIT_L(0); PG8_MMA(1, 0, At, B0); PG8_BAR; PG8_SCHED;
            PG8_STAGE(PG8_SB(1, 1), b3 + hstep, voffB);
            PG8_WAIT_V(6); PG8_BAR; PG8_MMA(1, 1, At, B1); PG8_BAR;
            }
        }
        if constexpr (ALIGN_EPI) { if (wr == 0) PG8_BAR; }
        if constexpr (!Epi::AFTER_DRAIN) { E(acc, cur, wr, wc, fr, fq); S.done(cur); }
        if (!has_next) break;
#pragma unroll
        for (int a = 0; a < 2; ++a)
#pragma unroll
            for (int b = 0; b < 2; ++b)
#pragma unroll
                for (int m = 0; m < 4; ++m)
#pragma unroll
                    for (int n = 0; n < 2; ++n) acc[a][b][m][n] = (f32x4){0.f, 0.f, 0.f, 0.f};
        cur = nxt; cA = nA; cB = nB; ++ui;
        if constexpr (ALIGN_EPI) { if (wr == 1) PG8_BAR; }
    }
    PG8_WAIT_V(0);
    if constexpr (!ALIGN_EPI) { if (wr == 0) PG8_BAR; }
    PG8_BAR;
    if constexpr (Epi::AFTER_DRAIN) { E.fused(acc, cur, wr, wc, fr, fq, lds, wid, lane); S.done(cur); }
#undef PG8_SA
#undef PG8_SB
#undef PG8_STAGE
#undef PG8_LDA
#undef PG8_LDB
#undef PG8_MMA
#undef PG8_WAIT_V
#undef PG8_WAIT_L
#undef PG8_BAR
#undef PG8_SCHED
}
}

constexpr size_t MiB = 1u << 20, KiB = 1u << 10;
constexpr size_t WS_CTL = 0, CTL_ZERO_BYTES = 1 * MiB;
constexpr size_t WS_RSTDX = 1 * MiB, WS_RSTD2 = WS_RSTDX + 128 * KiB, WS_RSTDM = WS_RSTD2 + 128 * KiB, WS_TOKPAIR = 1 * MiB + 512 * KiB;
constexpr size_t WS_ROUTE = 2 * MiB;
constexpr size_t WS_PAIRR = 3 * MiB, WS_PAIRW = 3 * MiB + 512 * KiB;
constexpr size_t WS_WR = 4 * MiB;
constexpr size_t WS_MEMB = 5 * MiB;
constexpr size_t WS_KVB = 9 * MiB;
constexpr size_t WS_WIN = 17 * MiB, WS_WOUT = 29 * MiB, WS_WKV = 35 * MiB, WS_WGU = 39 * MiB, WS_WD = 103 * MiB;
constexpr size_t WS_XB = 135 * MiB;
constexpr size_t WS_Y = 199 * MiB, WS_H = WS_Y;
constexpr size_t WS_U = 295 * MiB, WS_XG = WS_U, WS_YP = WS_U;
constexpr size_t WS_END = 487 * MiB;
static_assert(WS_U + (size_t)T * DIN * 2 <= WS_END && WS_XG + (size_t)(NPAIR + 256) * D * 2 <= WS_END && WS_H + (size_t)(NPAIR + 256) * DEXP * 2 <= WS_U, "d_ws map");
static_assert(WS_WD + (size_t)2 * NEXP * D * DEXP * 2 <= WS_XB && WS_WGU + (size_t)2 * NEXP * 512 * D * 2 <= WS_WD, "d_ws map (weights)");
constexpr int CW_BAR = 4096, CW_GCNT = 8192;

constexpr int RING_BYTES = 131072;
constexpr int TAB_OFF = RING_BYTES;
constexpr int TI_CNT = 0, TI_OFF = 64, TI_TS = 128, TI_HIST = 192, TI_BASE = 256;
constexpr int TF_BASE = 512;
constexpr int TF_GQ = TF_BASE, TF_DHG = TF_GQ + 64, TF_MQG = TF_DHG + 128, TF_MKG = TF_MQG + 128, TF_SC = TF_MKG + 128;
constexpr int MISC_OFF = TAB_OFF + 8192;
constexpr int LDS_BYTES = 147456;
static_assert((TF_SC + 16) * 4 <= 8192 && MISC_OFF + 128 <= LDS_BYTES, "LDS map");

typedef GAS unsigned gu32;
#define LDS_WAIT() asm volatile("s_waitcnt lgkmcnt(0)" ::: "memory")

#define XB_TMO      128
#define XB_XCNT(j)  (256  + 64 * (j))
#define XB_XSUB(j)  (1280 + 64 * (j))
#define XB_XGEN(j)  (2304 + 64 * (j))
#define XB_TOP      3328
#define XB_TOPGEN   3392
#define XCD_BAR_WORDS 3456
#define XB_SPIN_CAP (1u << 18)
__device__ __forceinline__ unsigned xb_ld(unsigned* p)              { return __hip_atomic_load(p, __ATOMIC_RELAXED, __HIP_MEMORY_SCOPE_AGENT); }
__device__ __forceinline__ unsigned xb_add(unsigned* p, unsigned v) { return __hip_atomic_fetch_add(p, v, __ATOMIC_RELAXED, __HIP_MEMORY_SCOPE_AGENT); }
__device__ __forceinline__ unsigned xb_xcc_id() { return (unsigned)__builtin_amdgcn_s_getreg((3 << 11) | 20) & 0xFu; }
#define XB_SPIN(cond, bar) do { unsigned _sp = 0; while (cond) { __builtin_amdgcn_s_sleep(1); \
    if ((++_sp & 255u) == 0u) { if (xb_ld(&(bar)[XB_TMO])) break; if (_sp > XB_SPIN_CAP) { atomicAdd(&(bar)[XB_TMO], 1u); break; } } } } while (0)

struct XcdBarrier {
    unsigned* bar; unsigned x;
    volatile LAS unsigned* st;
};

__device__ __forceinline__ XcdBarrier xcd_barrier_post(unsigned* bar, volatile LAS unsigned* st) {
    XcdBarrier b; b.bar = bar; b.x = xb_xcc_id(); b.st = st;
    if (threadIdx.x == 0) (void)xb_add(&bar[XB_XCNT(b.x)], 1u);
    return b;
}
__device__ __forceinline__ void xcd_barrier_complete(unsigned* bar, unsigned x, unsigned& nloc, unsigned& nx) {
    const unsigned G = gridDim.x * gridDim.y * gridDim.z;
    unsigned sum, cnt, mine, sp = 0u;
    for (;;) {
        sum = 0u; cnt = 0u; mine = 0u;
#pragma unroll
        for (unsigned j = 0; j < 16; ++j) { const unsigned c = xb_ld(&bar[XB_XCNT(j)]); sum += c; cnt += (c > 0u) ? 1u : 0u; mine = (j == x) ? c : mine; }
        if (sum == G) break;
        __builtin_amdgcn_s_sleep(1);
        if ((++sp & 255u) == 0u) { if (xb_ld(&bar[XB_TMO])) break; if (sp > XB_SPIN_CAP) { atomicAdd(&bar[XB_TMO], 1u); break; } }
    }
    nloc = mine > 0u ? mine : 1u; nx = cnt > 0u ? cnt : 1u;
}

__device__ __forceinline__ void xcd_barrier(const XcdBarrier& b) {
    asm volatile("s_waitcnt vmcnt(0)" ::: "memory");
    __syncthreads();
    if (threadIdx.x == 0) {
        unsigned* bar = b.bar;
        __builtin_amdgcn_s_waitcnt(0);
        unsigned nloc = b.st[0], nx = b.st[1];
        if (nloc == 0u) { xcd_barrier_complete(bar, b.x, nloc, nx); b.st[0] = nloc; b.st[1] = nx; }
        const unsigned old = xb_add(&bar[XB_XSUB(b.x)], 1u);
        const unsigned gen = old / nloc;
        if (old + 1u == (gen + 1u) * nloc) {
            __builtin_amdgcn_fence(__ATOMIC_RELEASE, "agent");
            asm volatile("s_waitcnt vmcnt(0)" ::: "memory");
            const unsigned og = xb_add(&bar[XB_TOP], 1u);
            const unsigned tg = og / nx;
            if (og + 1u == (tg + 1u) * nx) xb_add(&bar[XB_TOPGEN], 1u);
            else XB_SPIN(xb_ld(&bar[XB_TOPGEN]) == tg, bar);
            __builtin_amdgcn_fence(__ATOMIC_ACQUIRE, "agent");
            xb_add(&bar[XB_XGEN(b.x)], 1u);
            asm volatile("s_waitcnt vmcnt(0)" ::: "memory");
        } else {
            XB_SPIN(xb_ld(&bar[XB_XGEN(b.x)]) == gen, bar);
            __builtin_amdgcn_fence(__ATOMIC_ACQUIRE, "agent");
            asm volatile("s_waitcnt vmcnt(0)" ::: "memory");
        }
    }
    __syncthreads();
}

struct Ctx {
    LAS unsigned char* lds; LAS int* ti; LAS float* tf;
    int tid, lane, wave, G, vcu;
    float* out; unsigned char* ws;
};
typedef const float* cfp_t;
#define INP(i) (((const __attribute__((address_space(4))) cfp_t*)__builtin_amdgcn_kernarg_segment_ptr())[(i)])
enum InIdx { I_X = 0, I_MEM, I_N1G, I_WIN, I_CONVW, I_CONVB, I_WA, I_BA, I_WX, I_BX, I_LAMBDA, I_DQG, I_DKG, I_LQ1, I_LK1, I_LQ2, I_LK2, I_DHG, I_MEMG, I_WKV, I_MQG, I_MKG, I_WOUT, I_N2G,
             I_WRG, I_BRG, I_WRE, I_BRE, I_WEG, I_WEU, I_WED };
__device__ __forceinline__ float wave_sum(float v) {
    v += xswz<1>(v); v += xswz<2>(v); v += xswz<4>(v); v += xswz<8>(v); v += xswz<16>(v); v = xhalf_sum(v);
    return v;
}
__device__ __forceinline__ float wave_max(float v) {
    v = fmaxf(v, xswz<1>(v)); v = fmaxf(v, xswz<2>(v)); v = fmaxf(v, xswz<4>(v)); v = fmaxf(v, xswz<8>(v)); v = fmaxf(v, xswz<16>(v)); v = xhalf_max(v);
    return v;
}

__device__ __forceinline__ void p0_transpose_item(const float* W, int N, int K, bf16_t* WT, int dst_row0, const float* kscale, LAS float* scr, int k0, int n0, int lane) {
    float wv[32], sv[32];
#pragma unroll
    for (int i = 0; i < 32; ++i) { const int kk = 2 * i + (lane >> 5); wv[i] = W[(size_t)(k0 + kk) * N + n0 + (lane & 31)]; sv[i] = kscale ? kscale[k0 + kk] : 1.f; }
#pragma unroll
    for (int i = 0; i < 32; ++i) { const int kk = 2 * i + (lane >> 5); scr[kk * 33 + (lane & 31)] = wv[i] * sv[i]; }
    LDS_WAIT(); asm volatile("" ::: "memory");
    const int c = lane & 7;
#pragma unroll
    for (int j = 0; j < 4; ++j) { const int n = (lane >> 3) + 8 * j; const LAS float* s = scr + (8 * c) * 33 + n;
        u32x4 o; o.x = cvt_pk(s[0 * 33], s[1 * 33]); o.y = cvt_pk(s[2 * 33], s[3 * 33]); o.z = cvt_pk(s[4 * 33], s[5 * 33]); o.w = cvt_pk(s[6 * 33], s[7 * 33]);
        *(u32x4*)(WT + (size_t)(dst_row0 + n) * K + k0 + 8 * c) = o; }
    LDS_WAIT(); asm volatile("" ::: "memory");
}
__device__ __forceinline__ void row_to_bf16(const float* xrow, bf16_t* orow, float* rstd_out, int lane) {
    const f32x4* xr = (const f32x4*)xrow + lane; f32x4 v[4]; float s = 0.f;
#pragma unroll
    for (int j = 0; j < 4; ++j) { v[j] = xr[64 * j]; s += (v[j].x * v[j].x + v[j].y * v[j].y) + (v[j].z * v[j].z + v[j].w * v[j].w); }
    s = wave_sum(s);
    u32x2* o8 = (u32x2*)orow + lane;
#pragma unroll
    for (int j = 0; j < 4; ++j) { u32x2 w; w.x = cvt_pk(v[j].x, v[j].y); w.y = cvt_pk(v[j].z, v[j].w); o8[64 * j] = w; }
    if (lane == 0) *rstd_out = __builtin_amdgcn_rsqf(s * (1.f / D) + EPS);
}
__device__ __forceinline__ void row2_to_bf16(const float* xrow, bf16_t* orow, float* rstd_out, size_t estride, int rstride, int lane) {
    const f32x4* xa = (const f32x4*)xrow + lane; const f32x4* xb2 = (const f32x4*)(xrow + estride) + lane; f32x4 va[4], vb[4]; float sa = 0.f, sb = 0.f;
#pragma unroll
    for (int j = 0; j < 4; ++j) { va[j] = xa[64 * j]; vb[j] = xb2[64 * j]; }
#pragma unroll
    for (int j = 0; j < 4; ++j) { sa += (va[j].x * va[j].x + va[j].y * va[j].y) + (va[j].z * va[j].z + va[j].w * va[j].w); sb += (vb[j].x * vb[j].x + vb[j].y * vb[j].y) + (vb[j].z * vb[j].z + vb[j].w * vb[j].w); }
    sa = wave_sum(sa); sb = wave_sum(sb);
    u32x2* oa = (u32x2*)orow + lane; u32x2* ob = (u32x2*)(orow + estride) + lane;
#pragma unroll
    for (int j = 0; j < 4; ++j) { u32x2 w; w.x = cvt_pk(va[j].x, va[j].y); w.y = cvt_pk(va[j].z, va[j].w); oa[64 * j] = w; w.x = cvt_pk(vb[j].x, vb[j].y); w.y = cvt_pk(vb[j].z, vb[j].w); ob[64 * j] = w; }
    if (lane == 0) { rstd_out[0] = __builtin_amdgcn_rsqf(sa * (1.f / D) + EPS); rstd_out[rstride] = __builtin_amdgcn_rsqf(sb * (1.f / D) + EPS); }
}
__device__ __forceinline__ void p0_prologue(Ctx& F) {
    LAS float* scr = (LAS float*)(F.lds + F.wave * 16384);
    const int gw = F.vcu * NWAVES + F.wave, NGW = F.G * NWAVES;
    constexpr int I_IN = 16 * 96, I_OUT = 24 * 32, I_KV = 16 * 32, I_G = NEXP * 16 * 8, I_D = NEXP * 4 * 32, PER_L = I_IN + I_OUT + I_KV + 2 * I_G + I_D;
    bf16_t* Win = (bf16_t*)(F.ws + WS_WIN); bf16_t* Wout = (bf16_t*)(F.ws + WS_WOUT); bf16_t* Wkv = (bf16_t*)(F.ws + WS_WKV); bf16_t* Wgu = (bf16_t*)(F.ws + WS_WGU); bf16_t* Wd = (bf16_t*)(F.ws + WS_WD);
    for (int it = gw; it < DEPTH * PER_L; it += NGW) {
        const int l = it / PER_L; int r = it % PER_L;
        if (r < I_IN) { const int kb = r / 96, nb = r % 96, n0 = 32 * nb; int d0 = n0;
            if (n0 >= 1536 && n0 < 2048) { const int lt = n0 & 255, wc = lt >> 6, bj = (lt >> 5) & 1; d0 = (n0 & ~255) + 128 * bj + 32 * wc; }
            p0_transpose_item(INP(I_WIN) + (size_t)l * D * DIN, DIN, D, Win + (size_t)l * DIN * D, d0, INP(I_N1G) + l * D, scr, 64 * kb, n0, F.lane); continue; } r -= I_IN;
        if (r < I_OUT) { const int kb = r / 32, nb = r % 32;
            p0_transpose_item(INP(I_WOUT) + (size_t)l * DMIX * D, D, DMIX, Wout + (size_t)l * D * DMIX, 32 * nb, nullptr, scr, 64 * kb, 32 * nb, F.lane); continue; } r -= I_OUT;
        if (r < I_KV) { const int kb = r / 32, nb = r % 32;
            p0_transpose_item(INP(I_WKV) + (size_t)l * D * 1024, 1024, D, Wkv + (size_t)l * 1024 * D, 32 * nb, INP(I_MEMG), scr, 64 * kb, 32 * nb, F.lane); continue; } r -= I_KV;
        if (r < 2 * I_G) { const int up = r >= I_G; if (up) r -= I_G; const int e = r / 128, q = r % 128, kb = q / 8, nb = q % 8, n0 = 32 * nb;
            const int d0 = 256 * (n0 >> 7) + (n0 & 127) + (up ? 128 : 0);
            p0_transpose_item(INP(up ? I_WEU : I_WEG) + ((size_t)l * NEXP + e) * D * DEXP, DEXP, D, Wgu + ((size_t)l * NEXP + e) * 512 * D, d0, INP(I_N2G) + l * D, scr, 64 * kb, n0, F.lane); continue; } r -= 2 * I_G;
        { const int e = r / 128, q = r % 128, kb = q / 32, nb = q % 32;
            p0_transpose_item(INP(I_WED) + ((size_t)l * NEXP + e) * DEXP * D, D, DEXP, Wd + ((size_t)l * NEXP + e) * D * DEXP, 32 * nb, nullptr, scr, 64 * kb, 32 * nb, F.lane); }
    }
    for (int m = gw; m < T; m += 2 * NGW) row2_to_bf16(INP(I_X) + (size_t)m * D, (bf16_t*)(F.ws + WS_XB) + (size_t)m * D, (float*)(F.ws + WS_RSTDX) + m, (size_t)NGW * D, NGW, F.lane);
    for (int m = gw; m < TM; m += NGW) row_to_bf16(INP(I_MEM) + (size_t)m * D, (bf16_t*)(F.ws + WS_MEMB) + (size_t)m * D, (float*)(F.ws + WS_RSTDM) + m, F.lane);
    bf16_t* Wrh = (bf16_t*)(F.ws + WS_WR); bf16_t* Wrl = Wrh + (size_t)DEPTH * 48 * D;
    for (int idx = (F.vcu * NTHREADS + F.tid); idx < DEPTH * 48 * D; idx += F.G * NTHREADS) {
        const int l = idx / (48 * D), rem = idx % (48 * D), n = rem / D, k = rem % D; float v = 0.f;
        if (n < 4) v = INP(I_WRG)[((size_t)l * D + k) * 4 + n]; else if (n < 36) v = INP(I_WRE)[((size_t)l * D + k) * NEXP + (n - 4)];
        v *= INP(I_N2G)[l * D + k];
        const unsigned h = cvt_pk(v, 0.f) & 0xffffu; Wrh[idx] = (bf16_t)h; Wrl[idx] = (bf16_t)(cvt_pk(v - bf1((bf16_t)h), 0.f) & 0xffffu);
    }
}

namespace att {
constexpr int KCH = 1040;
constexpr int KIMG = 8 * KCH;
constexpr int VDC = 4160;
constexpr int VOFF = 2 * KIMG;
constexpr int BUF = VOFF + 4 * VDC;
static_assert(2 * BUF <= RING_BYTES && 4 * 16384 <= 2 * BUF, "attention LDS");
typedef short v4i16_t __attribute__((ext_vector_type(4)));
__device__ __forceinline__ f32x16 mfma32(bf16x8 a, bf16x8 b, f32x16 c) { return __builtin_amdgcn_mfma_f32_32x32x16_bf16(a, b, c, 0, 0, 0); }
__device__ __forceinline__ s16x4 vtr(const LAS unsigned char* p) { return __builtin_bit_cast(s16x4, __builtin_amdgcn_ds_read_tr16_b64_v4i16((LAS v4i16_t*)p)); }

template <int NS>
__device__ __forceinline__ void tile(const LAS unsigned char* kimg, const LAS unsigned char* vimg, const bf16x8 (&qf)[NS], f32x16 (&oT)[4], float& lsum, float negb, int lane, bool domask, int qi, int kv0) {
    const int i = lane & 31, h = lane >> 5;
    const int pi = (i & 0x13) | ((i & 4) << 1) | ((i & 8) >> 1);
    const LAS unsigned char* kb = kimg + h * KCH + pi * 16;
    const int qq = (lane & 15) >> 2, pp = lane & 3, blk = (lane >> 4) & 1;
    const LAS unsigned char* vb = vimg + (8 * h + qq) * 64 + blk * 32 + pp * 8;
#pragma unroll
    for (int hf = 0; hf < 2; ++hf) {
        f32x16 s;
#pragma unroll
        for (int r = 0; r < 16; ++r) s[r] = negb;
#pragma unroll
        for (int sl = 0; sl < NS; ++sl) { const bf16x8 kf = *(const LAS bf16x8*)(kb + sl * 2 * KCH + hf * 512); s = mfma32(kf, qf[sl], s); }
        float p[16];
#pragma unroll
        for (int r = 0; r < 16; ++r) p[r] = fast_exp2(s[r]);
        if (domask) {
#pragma unroll
            for (int r = 0; r < 16; ++r) { const int kv = kv0 + 32 * hf + 16 * (r >> 3) + 8 * h + (r & 7); if (kv > qi) p[r] = 0.f; }
        }
        float ps = 0.f;
#pragma unroll
        for (int r = 0; r < 16; ++r) ps += p[r];
        lsum += ps;
        bf16x8 pk[2];
#pragma unroll
        for (int sp = 0; sp < 2; ++sp) { u32x4 w; w.x = cvt_pk(p[8 * sp + 0], p[8 * sp + 1]); w.y = cvt_pk(p[8 * sp + 2], p[8 * sp + 3]); w.z = cvt_pk(p[8 * sp + 4], p[8 * sp + 5]); w.w = cvt_pk(p[8 * sp + 6], p[8 * sp + 7]); pk[sp] = __builtin_bit_cast(bf16x8, w); }
#pragma unroll
        for (int sp = 0; sp < 2; ++sp)
#pragma unroll
            for (int dc = 0; dc < 4; ++dc) {
                const s16x4 lo = vtr(vb + dc * VDC + (2 * hf + sp) * 1024), hi = vtr(vb + dc * VDC + (2 * hf + sp) * 1024 + 256);
                const bf16x8 vf = {lo[0], lo[1], lo[2], lo[3], hi[0], hi[1], hi[2], hi[3]};
                oT[dc] = mfma32(vf, pk[sp], oT[dc]);
            }
    }
}
__device__ __forceinline__ void stage_write(LAS unsigned char* buf, const u32x4 (&v)[4], int tid) {
    const int r16 = tid >> 4, c16 = tid & 15;
#pragma unroll
    for (int i = 0; i < 2; ++i) { const int kv = r16 + 32 * i;
        *(LAS u32x4*)(buf + c16 * KCH + kv * 16) = v[i];
        *(LAS u32x4*)(buf + VOFF + (c16 >> 2) * VDC + (kv >> 4) * 1024 + (kv & 15) * 64 + (c16 & 3) * 16) = v[2 + i]; }
}

__device__ __forceinline__ void diff_unit(Ctx& F, int l, int b, int hd, int qb) {
    const int tid = F.tid, lane = F.lane, wave = F.wave, qg = wave >> 1, c = wave & 1;
    const bf16_t* U = (const bf16_t*)(F.ws + WS_U); bf16_t* Y = (bf16_t*)(F.ws + WS_Y);
    const int tok0 = b * SEQ, q0 = 128 * qb, NT = 2 * qb + 2;
    const float lam = F.tf[TF_SC + 0], negb = -F.tf[TF_SC + 1];
    const float lam_init = (l == 0) ? 0.2f : 0.35550907f;
    bf16x8 qf[4];
    { const bf16_t* qrow = U + (size_t)(tok0 + q0 + 32 * qg + (lane & 31)) * DIN + 1024 + hd * 128 + c * 64 + 8 * (lane >> 5);
      u32x4 raw[4]; float ss = 0.f;
#pragma unroll
      for (int s = 0; s < 4; ++s) { raw[s] = *(const u32x4*)(qrow + 16 * s);
#pragma unroll
          for (int j = 0; j < 4; ++j) { const float a = bf_lo(raw[s][j]), bb = bf_hi(raw[s][j]); ss += a * a + bb * bb; } }
      ss = xhalf_sum(ss);
      const float rq = __builtin_amdgcn_rsqf(ss * (1.f / 64.f) + EPS) * (0.125f * LOG2E);
#pragma unroll
      for (int s = 0; s < 4; ++s) { const LAS float* g = F.tf + TF_GQ + 16 * s + 8 * (lane >> 5); u32x4 w;
#pragma unroll
          for (int j = 0; j < 4; ++j) w[j] = cvt_pk(bf_lo(raw[s][j]) * rq * g[2 * j], bf_hi(raw[s][j]) * rq * g[2 * j + 1]);
          qf[s] = __builtin_bit_cast(bf16x8, w); } }
    f32x16 oT[4];
#pragma unroll
    for (int dc = 0; dc < 4; ++dc)
#pragma unroll
        for (int r = 0; r < 16; ++r) oT[dc][r] = 0.f;
    float lsum = 0.f;
    const int r16 = tid >> 4, c16 = tid & 15;
    const bf16_t* kp = U + (size_t)(tok0 + r16) * DIN + 1536 + hd * 128 + c16 * 8;
    u32x4 st[4];
#define DIFF_LOAD(jt) do { const bf16_t* p_ = kp + (size_t)(64 * (jt)) * DIN; st[0] = *(const u32x4*)p_; st[1] = *(const u32x4*)(p_ + (size_t)32 * DIN); st[2] = *(const u32x4*)(p_ + 512); st[3] = *(const u32x4*)(p_ + (size_t)32 * DIN + 512); } while (0)
    DIFF_LOAD(0);
    stage_write(F.lds, st, tid);
    __syncthreads();
    const int qlo = q0 + 32 * qg, qi = qlo + (lane & 31);
    for (int jt = 0; jt < NT; ++jt) {
        LAS unsigned char* cur = F.lds + (jt & 1) * BUF; LAS unsigned char* nxt = F.lds + ((jt + 1) & 1) * BUF;
        if (jt + 1 < NT) DIFF_LOAD(jt + 1);
        if (64 * jt <= qlo + 31) tile<4>(cur + c * KIMG, cur + VOFF, qf, oT, lsum, negb, lane, 64 * jt + 63 > qlo, qi, 64 * jt);
        if (jt + 1 < NT) stage_write(nxt, st, tid);
        __syncthreads();
    }
#undef DIFF_LOAD
    lsum = xhalf_sum(lsum);
    const float inv = fast_rcp(lsum);
    LAS float* xb = (LAS float*)F.lds + (size_t)qg * 4096 + lane;
    if (c == 1) { const float sc = inv * lam;
#pragma unroll
        for (int dc = 0; dc < 4; ++dc)
#pragma unroll
            for (int r = 0; r < 16; ++r) xb[(dc * 16 + r) * 64] = oT[dc][r] * sc; }
    __syncthreads();
    if (c == 0) { float ss = 0.f;
#pragma unroll
        for (int dc = 0; dc < 4; ++dc)
#pragma unroll
            for (int r = 0; r < 16; ++r) { const float d = oT[dc][r] * inv - xb[(dc * 16 + r) * 64]; oT[dc][r] = d; ss += d * d; }
        ss = xhalf_sum(ss);
        const float rr = __builtin_amdgcn_rsqf(ss * (1.f / 128.f) + EPS) * (1.f - lam_init);
        bf16_t* yrow = Y + (size_t)(tok0 + qi) * DMIX + 512 + hd * 128 + 4 * (lane >> 5);
#pragma unroll
        for (int dc = 0; dc < 4; ++dc)
#pragma unroll
            for (int g4 = 0; g4 < 4; ++g4) { const f32x4 g = *(const LAS f32x4*)(F.tf + TF_DHG + 32 * dc + 8 * g4 + 4 * (lane >> 5));
                u32x2 w; w.x = cvt_pk(oT[dc][4 * g4 + 0] * rr * g[0], oT[dc][4 * g4 + 1] * rr * g[1]); w.y = cvt_pk(oT[dc][4 * g4 + 2] * rr * g[2], oT[dc][4 * g4 + 3] * rr * g[3]);
                *(u32x2*)(yrow + 32 * dc + 8 * g4) = w; } }
    __syncthreads();
}

__device__ __forceinline__ void mem_unit(Ctx& F, int l, int b, int mh, int qb) {
    const int tid = F.tid, lane = F.lane, wave = F.wave;
    const bf16_t* U = (const bf16_t*)(F.ws + WS_U); bf16_t* Y = (bf16_t*)(F.ws + WS_Y); const bf16_t* KV = (const bf16_t*)(F.ws + WS_KVB);
    const int tok = b * SEQ + 256 * qb + 32 * wave + (lane & 31);
    const float negb = -F.tf[TF_SC + 2];
    bf16x8 qf[8];
    { const bf16_t* qrow = U + (size_t)tok * DIN + 2560 + mh * 128 + 8 * (lane >> 5);
      u32x4 raw[8]; float ss = 0.f;
#pragma unroll
      for (int s = 0; s < 8; ++s) { raw[s] = *(const u32x4*)(qrow + 16 * s);
#pragma unroll
          for (int j = 0; j < 4; ++j) { const float a = bf_lo(raw[s][j]), bb = bf_hi(raw[s][j]); ss += a * a + bb * bb; } }
      ss = xhalf_sum(ss);
      const float rq = __builtin_amdgcn_rsqf(ss * (1.f / 128.f) + EPS) * (0.08838834764831845f * LOG2E);
#pragma unroll
      for (int s = 0; s < 8; ++s) { const LAS float* g = F.tf + TF_MQG + 16 * s + 8 * (lane >> 5); u32x4 w;
#pragma unroll
          for (int j = 0; j < 4; ++j) w[j] = cvt_pk(bf_lo(raw[s][j]) * rq * g[2 * j], bf_hi(raw[s][j]) * rq * g[2 * j + 1]);
          qf[s] = __builtin_bit_cast(bf16x8, w); } }
    f32x16 oT[4];
#pragma unroll
    for (int dc = 0; dc < 4; ++dc)
#pragma unroll
        for (int r = 0; r < 16; ++r) oT[dc][r] = 0.f;
    float lsum = 0.f;
    const int r16 = tid >> 4, c16 = tid & 15;
    const bf16_t* kp = KV + (size_t)(b * MEML + r16) * 2048 + l * 1024 + mh * 128 + c16 * 8;
    const LAS float* gk = F.tf + TF_MKG + 8 * c16;
    u32x4 st[4];
#define MEM_LOAD(jt) do { const bf16_t* p_ = kp + (size_t)(64 * (jt)) * 2048; st[0] = *(const u32x4*)p_; st[1] = *(const u32x4*)(p_ + (size_t)32 * 2048); st[2] = *(const u32x4*)(p_ + 512); st[3] = *(const u32x4*)(p_ + (size_t)32 * 2048 + 512); \
    _Pragma("unroll") for (int i_ = 0; i_ < 2; ++i_) { float f_[8]; float ss_ = 0.f; \
        _Pragma("unroll") for (int j_ = 0; j_ < 4; ++j_) { f_[2 * j_] = bf_lo(st[i_][j_]); f_[2 * j_ + 1] = bf_hi(st[i_][j_]); ss_ += f_[2 * j_] * f_[2 * j_] + f_[2 * j_ + 1] * f_[2 * j_ + 1]; } \
        ss_ += xswz<1>(ss_); ss_ += xswz<2>(ss_); ss_ += xswz<4>(ss_); ss_ += xswz<8>(ss_); \
        const float rk_ = __builtin_amdgcn_rsqf(ss_ * (1.f / 128.f) + EPS); \
        _Pragma("unroll") for (int j_ = 0; j_ < 4; ++j_) st[i_][j_] = cvt_pk(f_[2 * j_] * rk_ * gk[2 * j_], f_[2 * j_ + 1] * rk_ * gk[2 * j_ + 1]); } } while (0)
    for (int jt = 0; jt < 4; ++jt) {
        LAS unsigned char* cur = F.lds + (jt & 1) * BUF;
        MEM_LOAD(jt);
        stage_write(cur, st, tid);
        __syncthreads();
        tile<8>(cur, cur + VOFF, qf, oT, lsum, negb, lane, false, 0, 0);
    }
    __syncthreads();
#undef MEM_LOAD
    lsum = xhalf_sum(lsum);
    const float inv = fast_rcp(lsum);
    bf16_t* yrow = Y + (size_t)tok * DMIX + 1024 + mh * 128 + 4 * (lane >> 5);
#pragma unroll
    for (int dc = 0; dc < 4; ++dc)
#pragma unroll
        for (int g4 = 0; g4 < 4; ++g4) { u32x2 w; w.x = cvt_pk(oT[dc][4 * g4 + 0] * inv, oT[dc][4 * g4 + 1] * inv); w.y = cvt_pk(oT[dc][4 * g4 + 2] * inv, oT[dc][4 * g4 + 3] * inv);
            *(u32x2*)(yrow + 32 * dc + 8 * g4) = w; }
}
}

namespace lru {
constexpr int TC = 256, TCP = TC + 4;
constexpr int GP = (TC + 8) * 2;
constexpr int XRAW = 0, XC = 33280, XCP = 144, AR = XC + TC * XCP, AI = AR + 16 * TCP * 4, AX = AI + 16 * TCP * 4, GG = AX + 16 * TCP * 4, END = GG + 16 * GP, YL = XC;
static_assert(END <= RING_BYTES && 16 * GP <= TC * XCP, "lru LDS");
__device__ __forceinline__ float neg_expm1_small(float x) { float p = 1.f + x * (1.f / 7.f); p = 1.f + x * (1.f / 6.f) * p; p = 1.f + x * 0.2f * p; p = 1.f + x * 0.25f * p; p = 1.f + x * (1.f / 3.f) * p; p = 1.f + x * 0.5f * p; return -x * p; }
__device__ __forceinline__ float bperm(int byte_addr, float v) { return __int_as_float(__builtin_amdgcn_ds_bpermute(byte_addr, __float_as_int(v))); }
__device__ __forceinline__ void unit(Ctx& F, int l, int b, int j, int qtr) {
    const int tid = F.tid, lane = F.lane, wave = F.wave;
    const bf16_t* U = (const bf16_t*)(F.ws + WS_U); bf16_t* Y = (bf16_t*)(F.ws + WS_Y);
    const int tok0 = b * SEQ;
    const int cc = tid & 7, trow = tid >> 3;
    float cw[4][8], cb[8];
#pragma unroll
    for (int k = 0; k < 8; ++k) { cb[k] = INP(I_CONVB)[l * GW + 64 * j + 8 * cc + k];
#pragma unroll
        for (int w = 0; w < 4; ++w) cw[w][k] = INP(I_CONVW)[((size_t)l * 4 + w) * GW + 64 * j + 8 * cc + k]; }
    bf16x8 bA[2], bX[2], bI[2];
    { const int n = lane & 15, kq = lane >> 4;
      const float* wa = INP(I_WA) + ((size_t)l * 8 + j) * 4096 + 16 * qtr + n; const float* wx = INP(I_WX) + ((size_t)l * 8 + j) * 4096 + 16 * qtr + n;
#pragma unroll
      for (int ks = 0; ks < 2; ++ks) { u32x4 a, x, id;
#pragma unroll
          for (int jj = 0; jj < 4; ++jj) { const int k0 = 32 * ks + 8 * kq + 2 * jj; a[jj] = cvt_pk(wa[(size_t)k0 * 64], wa[(size_t)(k0 + 1) * 64]); x[jj] = cvt_pk(wx[(size_t)k0 * 64], wx[(size_t)(k0 + 1) * 64]);
              id[jj] = (k0 == 16 * qtr + n ? 0x3f80u : 0u) | (k0 + 1 == 16 * qtr + n ? 0x3f800000u : 0u); }
          bA[ks] = __builtin_bit_cast(bf16x8, a); bX[ks] = __builtin_bit_cast(bf16x8, x); bI[ks] = __builtin_bit_cast(bf16x8, id); } }
    const float ba_n = INP(I_BA)[l * GW + 64 * j + 16 * qtr + (lane & 15)], bx_n = INP(I_BX)[l * GW + 64 * j + 16 * qtr + (lane & 15)];
    const int c = tid >> 5, seg = tid & 31;
    const float kc = -8.f * log1pf(expf(-INP(I_LAMBDA)[l * GW + 64 * j + 16 * qtr + c]));
    float carry = 0.f;
    const int tt = tid >> 1, th = tid & 1;
    const bf16_t* gsrc = U + (size_t)(tok0 + tt) * DIN + 512 + 64 * j + 16 * qtr + 8 * th;
    bf16_t* ydst = Y + (size_t)(tok0 + tt) * DMIX + 64 * j + 16 * qtr + 8 * th;
    u32x4 xr[5], gr;
#define LRU_PREFETCH(t0_) do { _Pragma("unroll") for (int i_ = 0; i_ < 5; ++i_) { const int idx_ = tid + NTHREADS * i_, r_ = idx_ >> 3, c8_ = idx_ & 7, t_ = (t0_) - 3 + r_; xr[i_] = (u32x4){0u, 0u, 0u, 0u}; \
        if (idx_ < 259 * 8 && t_ >= 0) xr[i_] = *(const u32x4*)(U + (size_t)(tok0 + t_) * DIN + 64 * j + 8 * c8_); } \
        gr = *(const u32x4*)(gsrc + (size_t)(t0_) * DIN); } while (0)
    LRU_PREFETCH(0);
    for (int ck = 0; ck < SEQ / TC; ++ck) {
        const int t0 = ck * TC;
#pragma unroll
        for (int i = 0; i < 5; ++i) { const int idx = tid + NTHREADS * i; if (idx < 259 * 8) *(LAS u32x4*)(F.lds + XRAW + (idx >> 3) * 128 + (idx & 7) * 16) = xr[i]; }
#pragma unroll
        for (int k = 0; k < 4; ++k) { *(LAS bf16_t*)(F.lds + GG + (8 * th + 2 * k) * GP + tt * 2) = (bf16_t)(gr[k] & 0xffffu); *(LAS bf16_t*)(F.lds + GG + (8 * th + 2 * k + 1) * GP + tt * 2) = (bf16_t)(gr[k] >> 16); }
        __syncthreads();
        if (ck + 1 < SEQ / TC) LRU_PREFETCH(t0 + TC);
#pragma unroll
        for (int i = 0; i < 4; ++i) { const int t = trow + 64 * i; float xc[8];
#pragma unroll
            for (int k = 0; k < 8; ++k) xc[k] = cb[k];
#pragma unroll
            for (int w = 0; w < 4; ++w) { const u32x4 v = *(const LAS u32x4*)(F.lds + XRAW + (t + w) * 128 + cc * 16);
#pragma unroll
                for (int k = 0; k < 4; ++k) { xc[2 * k] += cw[w][2 * k] * bf_lo(v[k]); xc[2 * k + 1] += cw[w][2 * k + 1] * bf_hi(v[k]); } }
            u32x4 o; o.x = cvt_pk(xc[0], xc[1]); o.y = cvt_pk(xc[2], xc[3]); o.z = cvt_pk(xc[4], xc[5]); o.w = cvt_pk(xc[6], xc[7]);
            *(LAS u32x4*)(F.lds + XC + t * XCP + cc * 16) = o; }
        __syncthreads();
#pragma unroll
        for (int r2 = 0; r2 < 2; ++r2) { const int rt = 2 * wave + r2; f32x4 aa = {0.f, 0.f, 0.f, 0.f}, ax = aa, ai = aa;
#pragma unroll
            for (int ks = 0; ks < 2; ++ks) { const bf16x8 af = *(const LAS bf16x8*)(F.lds + XC + (16 * rt + (lane & 15)) * XCP + (32 * ks + 8 * (lane >> 4)) * 2);
                aa = __builtin_amdgcn_mfma_f32_16x16x32_bf16(af, bA[ks], aa, 0, 0, 0); ax = __builtin_amdgcn_mfma_f32_16x16x32_bf16(af, bX[ks], ax, 0, 0, 0); ai = __builtin_amdgcn_mfma_f32_16x16x32_bf16(af, bI[ks], ai, 0, 0, 0); }
            f32x4 vr, vi;
#pragma unroll
            for (int r = 0; r < 4; ++r) { vr[r] = sigmoidf_(aa[r] + ba_n); vi[r] = sigmoidf_(ax[r] + bx_n); }
            const int o = ((lane & 15) * TCP + 16 * rt + 4 * (lane >> 4)) * 4;
            *(LAS f32x4*)(F.lds + AR + o) = vr; *(LAS f32x4*)(F.lds + AI + o) = vi; *(LAS f32x4*)(F.lds + AX + o) = ai; }
        __syncthreads();
        float av[8], bv[8], A = 1.f, Bv = 0.f;
        { const int o = (c * TCP + 8 * seg) * 4;
          const f32x4 r0 = *(const LAS f32x4*)(F.lds + AR + o), r1 = *(const LAS f32x4*)(F.lds + AR + o + 16), i0 = *(const LAS f32x4*)(F.lds + AI + o), i1 = *(const LAS f32x4*)(F.lds + AI + o + 16),
                      x0 = *(const LAS f32x4*)(F.lds + AX + o), x1 = *(const LAS f32x4*)(F.lds + AX + o + 16);
#pragma unroll
          for (int k = 0; k < 8; ++k) { const float r = k < 4 ? r0[k & 3] : r1[k & 3], ig = k < 4 ? i0[k & 3] : i1[k & 3], xv = k < 4 ? x0[k & 3] : x1[k & 3];
              const float la = r * kc; av[k] = fast_exp2(la * LOG2E); const float om = (la < -0.125f) ? (1.f - av[k] * av[k]) : neg_expm1_small(2.f * la); bv[k] = __builtin_sqrtf(om) * (ig * xv);
              A *= av[k]; Bv = av[k] * Bv + bv[k]; } }
        const u32x4 g8 = *(const LAS u32x4*)(F.lds + GG + c * GP + 8 * seg * 2);
        float Ai = A, Bi = Bv;
#pragma unroll
        for (int d = 1; d < 32; d <<= 1) { const int src = (lane - d) * 4; const float Ap = bperm(src, Ai), Bp = bperm(src, Bi); if (seg >= d) { Bi = Ai * Bp + Bi; Ai = Ai * Ap; } }
        float Ae = bperm((lane - 1) * 4, Ai), Be = bperm((lane - 1) * 4, Bi); if (seg == 0) { Ae = 1.f; Be = 0.f; }
        const float Al = bperm((lane | 31) * 4, Ai), Bl = bperm((lane | 31) * 4, Bi);
        float h = Ae * carry + Be; carry = Al * carry + Bl;
        { float yv[8];
#pragma unroll
          for (int k = 0; k < 8; ++k) { h = av[k] * h + bv[k]; const float g = (k & 1) ? bf_hi(g8[k >> 1]) : bf_lo(g8[k >> 1]);
              const float z = 1.5957691216057308f * (g + 0.044715f * g * g * g); yv[k] = h * g * sigmoidf_(z); }
          u32x4 o; o.x = cvt_pk(yv[0], yv[1]); o.y = cvt_pk(yv[2], yv[3]); o.z = cvt_pk(yv[4], yv[5]); o.w = cvt_pk(yv[6], yv[7]);
          *(LAS u32x4*)(F.lds + YL + c * GP + 8 * seg * 2) = o; }
        __syncthreads();
        { u32x4 o;
#pragma unroll
          for (int k = 0; k < 4; ++k) { const unsigned lo = *(const LAS bf16_t*)(F.lds + YL + (8 * th + 2 * k) * GP + tt * 2), hi = *(const LAS bf16_t*)(F.lds + YL + (8 * th + 2 * k + 1) * GP + tt * 2); o[k] = lo | (hi << 16); }
          *(u32x4*)(ydst + (size_t)t0 * DMIX) = o; }
    }
#undef LRU_PREFETCH
    __syncthreads();
}
}

__device__ __forceinline__ void p2_mixer(Ctx& F, int l) {
    if (F.tid < 64) F.tf[TF_GQ + F.tid] = INP(I_DQG)[l * 64 + F.tid];
    if (F.tid < 128) { F.tf[TF_DHG + F.tid] = INP(I_DHG)[l * 128 + F.tid]; F.tf[TF_MQG + F.tid] = INP(I_MQG)[l * 128 + F.tid]; F.tf[TF_MKG + F.tid] = INP(I_MKG)[l * 128 + F.tid]; }
    if (F.wave == 0) {
        const int ln = F.lane; const float lam_init = (l == 0) ? 0.2f : 0.35550907f;
        const float s1 = wave_sum(INP(I_LQ1)[l * 64 + ln] * INP(I_LK1)[l * 64 + ln]), s2 = wave_sum(INP(I_LQ2)[l * 64 + ln] * INP(I_LK2)[l * 64 + ln]);
        const float mq = wave_max(fabsf(INP(I_DQG)[l * 64 + ln])), mk = wave_max(fabsf(INP(I_DKG)[l * 64 + ln]));
        const float mmq = wave_max(fmaxf(fabsf(INP(I_MQG)[l * 128 + ln]), fabsf(INP(I_MQG)[l * 128 + 64 + ln]))), mmk = wave_max(fmaxf(fabsf(INP(I_MKG)[l * 128 + ln]), fabsf(INP(I_MKG)[l * 128 + 64 + ln])));
        if (ln == 0) { F.tf[TF_SC + 0] = expf(s1) - expf(s2) + lam_init; F.tf[TF_SC + 1] = 8.f * mq * mk * LOG2E; F.tf[TF_SC + 2] = 11.313708498984761f * mmq * mmk * LOG2E; }
    }
    __syncthreads();
    if (KIND(2)) for (int rp = 0; rp < NREP(2); ++rp) for (int u = F.vcu; u < 256; u += F.G) lru::unit(F, l, u >> 5, (u >> 2) & 7, u & 3);
    if (KIND(3)) for (int rp = 0; rp < NREP(3); ++rp) for (int dp = F.vcu; dp < 512; dp += F.G) {
        const int x = (dp & 255) >> 5, w = dp & 31, pu = w + 32 * (dp >> 8), bh = x + 8 * (pu >> 4), pr = pu & 15;
        att::diff_unit(F, l, bh >> 2, bh & 3, 31 - pr);
        att::diff_unit(F, l, bh >> 2, bh & 3, pr);
    }
    if (KIND(4)) for (int rp = 0; rp < NREP(4); ++rp) for (int mu = F.vcu; mu < 512; mu += F.G) { const int bh = mu >> 4; att::mem_unit(F, l, bh >> 2, bh & 3, mu & 15); }
}

__device__ __forceinline__ void p4_router(Ctx& F, int l) {
    const int lane = F.lane, wave = F.wave, tid = F.tid, rg = wave >> 2, kw = wave & 3, kq = lane >> 4;
    const float* X = F.out; bf16_t* XB = (bf16_t*)(F.ws + WS_XB);
    const bf16_t* Wh = (const bf16_t*)(F.ws + WS_WR) + (size_t)l * 48 * D; const bf16_t* Wl = Wh + (size_t)DEPTH * 48 * D;
    float* rstd2 = (float*)(F.ws + WS_RSTD2); unsigned* route = (unsigned*)(F.ws + WS_ROUTE); unsigned* gcnt = (unsigned*)(F.ws + WS_CTL) + CW_GCNT + 64 * l;
    constexpr int PP = 49;
    LAS float* P = (LAS float*)(F.lds); LAS float* SS = P + 4 * 128 * PP;
    LAS int* hist = F.ti + TI_HIST; LAS int* base = F.ti + TI_BASE;
    for (int it = blockIdx.x; it < T / 128; it += F.G) {
        if (tid < NEXP) hist[tid] = 0;
        const int row0 = it * 128 + 64 * rg;
        const float* xr = X + (size_t)(row0 + (lane & 15)) * D + 256 * kw + 8 * kq; bf16_t* xo = XB + (size_t)(row0 + (lane & 15)) * D + 256 * kw + 8 * kq;
        const bf16_t* wh = Wh + (size_t)(lane & 15) * D + 256 * kw + 8 * kq; const bf16_t* wl = Wl + (size_t)(lane & 15) * D + 256 * kw + 8 * kq;
        f32x4 acc[4][3]; float ss[4];
#pragma unroll
        for (int rt = 0; rt < 4; ++rt) { ss[rt] = 0.f;
#pragma unroll
            for (int ct = 0; ct < 3; ++ct) acc[rt][ct] = (f32x4){0.f, 0.f, 0.f, 0.f}; }
#pragma unroll 2
        for (int ks = 0; ks < 8; ++ks) {
            bf16x8 bh[3], bl[3];
#pragma unroll
            for (int ct = 0; ct < 3; ++ct) { bh[ct] = *(const bf16x8*)(wh + (size_t)16 * ct * D + 32 * ks); bl[ct] = *(const bf16x8*)(wl + (size_t)16 * ct * D + 32 * ks); }
#pragma unroll
            for (int rt = 0; rt < 4; ++rt) {
                const f32x4 a0 = *(const f32x4*)(xr + (size_t)16 * rt * D + 32 * ks), a1 = *(const f32x4*)(xr + (size_t)16 * rt * D + 32 * ks + 4);
                ss[rt] += ((a0[0] * a0[0] + a0[1] * a0[1]) + (a0[2] * a0[2] + a0[3] * a0[3])) + ((a1[0] * a1[0] + a1[1] * a1[1]) + (a1[2] * a1[2] + a1[3] * a1[3]));
                u32x4 hi; hi.x = cvt_pk(a0[0], a0[1]); hi.y = cvt_pk(a0[2], a0[3]); hi.z = cvt_pk(a1[0], a1[1]); hi.w = cvt_pk(a1[2], a1[3]);
                u32x4 lo; lo.x = cvt_pk(a0[0] - bf_lo(hi.x), a0[1] - bf_hi(hi.x)); lo.y = cvt_pk(a0[2] - bf_lo(hi.y), a0[3] - bf_hi(hi.y)); lo.z = cvt_pk(a1[0] - bf_lo(hi.z), a1[1] - bf_hi(hi.z)); lo.w = cvt_pk(a1[2] - bf_lo(hi.w), a1[3] - bf_hi(hi.w));
                *(u32x4*)(xo + (size_t)16 * rt * D + 32 * ks) = hi;
                const bf16x8 ah = __builtin_bit_cast(bf16x8, hi), al = __builtin_bit_cast(bf16x8, lo);
#pragma unroll
                for (int ct = 0; ct < 3; ++ct) { acc[rt][ct] = __builtin_amdgcn_mfma_f32_16x16x32_bf16(ah, bh[ct], acc[rt][ct], 0, 0, 0); acc[rt][ct] = __builtin_amdgcn_mfma_f32_16x16x32_bf16(al, bh[ct], acc[rt][ct], 0, 0, 0);
                    acc[rt][ct] = __builtin_amdgcn_mfma_f32_16x16x32_bf16(ah, bl[ct], acc[rt][ct], 0, 0, 0); }
            }
        }
#pragma unroll
        for (int rt = 0; rt < 4; ++rt) { float s = ss[rt]; s += xswz<16>(s); s = xhalf_sum(s);
            if (kq == 0) SS[kw * 128 + 64 * rg + 16 * rt + (lane & 15)] = s;
#pragma unroll
            for (int ct = 0; ct < 3; ++ct)
#pragma unroll
                for (int r = 0; r < 4; ++r) P[(kw * 128 + 64 * rg + 16 * rt + 4 * kq + r) * PP + 16 * ct + (lane & 15)] = acc[rt][ct][r]; }
        __syncthreads();
        int e0 = 0, e1 = 0, lp0 = 0, lp1 = 0; float cw0 = 0.f, cw1 = 0.f, rs = 0.f;
        if (tid < 128) {
            const float ssum = (SS[tid] + SS[128 + tid]) + (SS[256 + tid] + SS[384 + tid]);
            rs = __builtin_amdgcn_rsqf(ssum * (1.f / D) + EPS);
            const LAS float* L0 = P + tid * PP; const float* brg = INP(I_BRG) + l * 4; const float* bre = INP(I_BRE) + l * NEXP;
#define LG(k) (((L0[(k)] + L0[128 * PP + (k)]) + (L0[256 * PP + (k)] + L0[384 * PP + (k)])) * rs)
            float gl[4]; float g0; int gi = 0;
#pragma unroll
            for (int k = 0; k < 4; ++k) gl[k] = LG(k) + brg[k];
            g0 = gl[0];
#pragma unroll
            for (int k = 1; k < 4; ++k) if (gl[k] > g0) { g0 = gl[k]; gi = k; }
            float den = 0.f;
#pragma unroll
            for (int k = 0; k < 4; ++k) den += expf(gl[k] - g0);
            const float gate = 1.f / den;
            float le[8];
#pragma unroll
            for (int k = 0; k < 8; ++k) le[k] = LG(4 + 8 * gi + k) + bre[8 * gi + k];
#undef LG
            float m0 = le[0]; int i0 = 0;
#pragma unroll
            for (int k = 1; k < 8; ++k) if (le[k] > m0) { m0 = le[k]; i0 = k; }
            float m1 = -INFINITY; int i1 = 0;
#pragma unroll
            for (int k = 0; k < 8; ++k) if (k != i0 && le[k] > m1) { m1 = le[k]; i1 = k; }
            const float ex = expf(m1 - m0), w0v = 1.f / (1.f + ex);
            cw0 = gate * w0v; cw1 = gate * (ex * w0v); e0 = 8 * gi + i0; e1 = 8 * gi + i1;
            lp0 = __hip_atomic_fetch_add(hist + e0, 1, __ATOMIC_RELAXED, __HIP_MEMORY_SCOPE_WORKGROUP);
            lp1 = __hip_atomic_fetch_add(hist + e1, 1, __ATOMIC_RELAXED, __HIP_MEMORY_SCOPE_WORKGROUP);
        }
        __syncthreads();
        if (tid < NEXP) base[tid] = (int)__hip_atomic_fetch_add(gcnt + tid, (unsigned)hist[tid], __ATOMIC_RELAXED, __HIP_MEMORY_SCOPE_AGENT);
        __syncthreads();
        if (tid < 128) { const int row = it * 128 + tid; u32x4 r0, r1; r0.x = (unsigned)e0; r0.y = (unsigned)(base[e0] + lp0); r0.z = (unsigned)e1; r0.w = (unsigned)(base[e1] + lp1);
            r1.x = __float_as_uint(cw0); r1.y = __float_as_uint(cw1); r1.z = __float_as_uint(rs); r1.w = 0u;
            *(u32x4*)(route + (size_t)row * 8) = r0; *(u32x4*)(route + (size_t)row * 8 + 4) = r1; rstd2[row] = rs; }
        __syncthreads();
    }
}
__device__ __forceinline__ void moe_tables(Ctx& F, int l) {
    const unsigned* gcnt = (const unsigned*)(F.ws + WS_CTL) + CW_GCNT + 64 * l;
    if (F.tid < NEXP) F.ti[TI_CNT + F.tid] = (int)__hip_atomic_load(gcnt + F.tid, __ATOMIC_RELAXED, __HIP_MEMORY_SCOPE_AGENT);
    __syncthreads();
    if (F.tid == 0) { int o = 0, t = 0; for (int e = 0; e < NEXP; ++e) { F.ti[TI_OFF + e] = o; F.ti[TI_TS + e] = t; const int c = F.ti[TI_CNT + e]; o += c; t += (c + 255) >> 8; } F.ti[TI_OFF + NEXP] = o; F.ti[TI_TS + NEXP] = t; }
    __syncthreads();
}
__device__ __forceinline__ void p5_gather(Ctx& F, int l) {
    moe_tables(F, l);
    const int gw = F.vcu * NWAVES + F.wave, NGW = F.G * NWAVES, lane = F.lane;
    const bf16_t* XB = (const bf16_t*)(F.ws + WS_XB); bf16_t* XG = (bf16_t*)(F.ws + WS_XG); const unsigned* route = (const unsigned*)(F.ws + WS_ROUTE);
    float* pr = (float*)(F.ws + WS_PAIRR); float* pw = (float*)(F.ws + WS_PAIRW); int* tokpair = (int*)(F.ws + WS_TOKPAIR);
    for (int m = gw; m < T; m += NGW) {
        const u32x4 r0 = *(const u32x4*)(route + (size_t)m * 8), r1 = *(const u32x4*)(route + (size_t)m * 8 + 4);
        const int p0 = F.ti[TI_OFF + (int)r0.x] + (int)r0.y, p1 = F.ti[TI_OFF + (int)r0.z] + (int)r0.w;
        const u32x4* src = (const u32x4*)(XB + (size_t)m * D) + lane; const u32x4 v0 = src[0], v1 = src[64];
        u32x4* d0 = (u32x4*)(XG + (size_t)p0 * D) + lane; u32x4* d1 = (u32x4*)(XG + (size_t)p1 * D) + lane;
        d0[0] = v0; d0[64] = v1; d1[0] = v0; d1[64] = v1;
        if (lane == 0) { pr[p0] = __uint_as_float(r1.z); pw[p0] = __uint_as_float(r1.x); pr[p1] = __uint_as_float(r1.z); pw[p1] = __uint_as_float(r1.y); tokpair[2 * m] = p0; tokpair[2 * m + 1] = p1; }
    }
}
__device__ __forceinline__ void p8_combine(Ctx& F, int l) {
    const int gw = F.vcu * NWAVES + F.wave, NGW = F.G * NWAVES, lane = F.lane;
    float* X = F.out; const bf16_t* YP = (const bf16_t*)(F.ws + WS_YP); const int* tokpair = (const int*)(F.ws + WS_TOKPAIR);
    bf16_t* XB = (bf16_t*)(F.ws + WS_XB); float* rstdx = (float*)(F.ws + WS_RSTDX);
    for (int m = gw; m < T; m += NGW) {
        const int p0 = tokpair[2 * m], p1 = tokpair[2 * m + 1];
        f32x4* xr = (f32x4*)(X + (size_t)m * D) + lane; const u32x2* y0 = (const u32x2*)(YP + (size_t)p0 * D) + lane; const u32x2* y1 = (const u32x2*)(YP + (size_t)p1 * D) + lane;
        f32x4 v[4]; float s = 0.f;
#pragma unroll
        for (int j = 0; j < 4; ++j) { const f32x4 x = xr[64 * j]; const u32x2 a = y0[64 * j], b = y1[64 * j];
            v[j].x = x.x + bf_lo(a.x) + bf_lo(b.x); v[j].y = x.y + bf_hi(a.x) + bf_hi(b.x); v[j].z = x.z + bf_lo(a.y) + bf_lo(b.y); v[j].w = x.w + bf_hi(a.y) + bf_hi(b.y);
            xr[64 * j] = v[j]; s += (v[j].x * v[j].x + v[j].y * v[j].y) + (v[j].z * v[j].z + v[j].w * v[j].w); }
        if (l + 1 < DEPTH) {
            s = wave_sum(s);
            u32x2* o8 = (u32x2*)(XB + (size_t)m * D) + lane;
#pragma unroll
            for (int j = 0; j < 4; ++j) { u32x2 w; w.x = cvt_pk(v[j].x, v[j].y); w.y = cvt_pk(v[j].z, v[j].w); o8[64 * j] = w; }
            if (lane == 0) rstdx[m] = __builtin_amdgcn_rsqf(s * (1.f / D) + EPS);
        }
    }
}

#ifndef MK_N_LAUNCHES
#define MK_N_LAUNCHES 1
#endif
constexpr int NPH = 1 + 8 * DEPTH;
struct Args { const float* in[31]; float* out; unsigned char* ws; int ph_lo, ph_hi; };
__global__ void __launch_bounds__(NTHREADS, 2) hymba_fwd(Args args) {
    extern __shared__ __attribute__((aligned(16))) unsigned char lds[];
    Ctx F;
    F.lds = (LAS unsigned char*)lds; F.ti = (LAS int*)(F.lds + TAB_OFF); F.tf = (LAS float*)(F.lds + TAB_OFF);
    F.tid = threadIdx.x; F.lane = F.tid & 63; F.wave = __builtin_amdgcn_readfirstlane(F.tid >> 6);
    F.G = gridDim.x; { const int bx = blockIdx.x; F.vcu = (F.G % 8 == 0) ? (bx % 8) * (F.G / 8) + bx / 8 : bx; }
    F.out = args.out; F.ws = args.ws;
    volatile LAS unsigned* MISC = (volatile LAS unsigned*)(F.lds + MISC_OFF);
    if (F.tid < 32) MISC[F.tid] = 0u;
    __syncthreads();
    XcdBarrier bar; bar.bar = (unsigned*)(F.ws + WS_CTL) + CW_BAR; bar.x = 0; bar.st = nullptr;
    if (MK_N_LAUNCHES == 1) bar = xcd_barrier_post((unsigned*)(F.ws + WS_CTL) + CW_BAR, MISC + 8);
    const int lo = args.ph_lo, hi = args.ph_hi;
#define IN(k) (lo <= (k) && (k) < hi)
#define SEAM(k) do { if (IN(k) && IN((k) + 1)) xcd_barrier(bar); asm volatile("" : "+v"(F.tid)); F.lane = F.tid & 63; F.wave = __builtin_amdgcn_readfirstlane(F.tid >> 6); } while (0)
    if (KIND(0) && IN(0)) for (int rp = 0; rp < NREP(0); ++rp) { p0_prologue(F); } SEAM(0);
#pragma unroll 1
    for (int l = 0; l < DEPTH; ++l) {
        const int pb = 1 + 8 * l;
        if (KIND(1) && IN(pb + 0)) for (int rp = 0; rp < NREP(1); ++rp) {
            { pg8::DenseOrder S; S.init((const bf16_t*)(F.ws + WS_XB), (const bf16_t*)(F.ws + WS_WIN) + (size_t)l * DIN * D, T, DIN, D, F.G, (int)blockIdx.x);
              pg8::EpiIn E{(bf16_t*)(F.ws + WS_U), DIN, (const float*)(F.ws + WS_RSTDX), INP(I_DKG) + l * 64, 1536, 2048};
              pg8::gemm_phase<pg8::EpiIn, pg8::DenseOrder, true, true>(F.lds, D, S, E); }
            if (l == 0) { pg8::DenseOrder S; S.init((const bf16_t*)(F.ws + WS_MEMB), (const bf16_t*)(F.ws + WS_WKV), TM, 2048, D, F.G, (int)blockIdx.x);
              pg8::EpiIn E{(bf16_t*)(F.ws + WS_KVB), 2048, (const float*)(F.ws + WS_RSTDM), nullptr, 0, 0};
              pg8::gemm_phase<pg8::EpiIn, pg8::DenseOrder, true, true>(F.lds, D, S, E); }
        } SEAM(pb + 0);
        if ((KIND(2) || KIND(3) || KIND(4)) && IN(pb + 1)) { p2_mixer(F, l); } SEAM(pb + 1);
        if (KIND(5) && IN(pb + 2)) {
            pg8::DenseOrder S; S.init((const bf16_t*)(F.ws + WS_Y), (const bf16_t*)(F.ws + WS_WOUT) + (size_t)l * D * DMIX, T, D, DMIX, F.G, (int)blockIdx.x);
            pg8::EpiOutRes E{l == 0 ? INP(I_X) : F.out, F.out, D};
            pg8::gemm_phase<pg8::EpiOutRes, pg8::DenseOrder, true, true>(F.lds, DMIX, S, E);
        } SEAM(pb + 2);
        if (KIND(6) && IN(pb + 3)) { p4_router(F, l); } SEAM(pb + 3);
        if (KIND(7) && IN(pb + 4)) for (int rp = 0; rp < NREP(7); ++rp) { p5_gather(F, l); } SEAM(pb + 4);
        if (KIND(8) && IN(pb + 5)) for (int rp = 0; rp < NREP(8); ++rp) {
            moe_tables(F, l);
            pg8::MoeOrder S{F.ti + TI_CNT, F.ti + TI_OFF, F.ti + TI_TS, (const char*)(F.ws + WS_XG), (const char*)((const bf16_t*)(F.ws + WS_WGU) + (size_t)l * NEXP * 512 * D), D, 2, 512, 128, F.G, (int)blockIdx.x};
            pg8::EpiMoe1 E{(bf16_t*)(F.ws + WS_H), (const float*)(F.ws + WS_PAIRR), (const float*)(F.ws + WS_PAIRW)};
            pg8::gemm_phase<pg8::EpiMoe1, pg8::MoeOrder, true, true>(F.lds, D, S, E);
        } SEAM(pb + 5);
        if (KIND(9) && IN(pb + 6)) for (int rp = 0; rp < NREP(9); ++rp) {
            moe_tables(F, l);
            pg8::MoeOrder S{F.ti + TI_CNT, F.ti + TI_OFF, F.ti + TI_TS, (const char*)(F.ws + WS_H), (const char*)((const bf16_t*)(F.ws + WS_WD) + (size_t)l * NEXP * D * DEXP), DEXP, 4, 1024, 256, F.G, (int)blockIdx.x};
            pg8::EpiMoe2 E{(bf16_t*)(F.ws + WS_YP)};
            pg8::gemm_phase<pg8::EpiMoe2, pg8::MoeOrder, true, true>(F.lds, DEXP, S, E);
        } SEAM(pb + 6);
        if (KIND(10) && IN(pb + 7)) { p8_combine(F, l); } SEAM(pb + 7);
    }
#undef IN
#undef SEAM
}

extern "C" void kernel_launch(void* const* d_in, const int* in_sizes, int n_in, void* d_out, int out_size, void* d_ws, size_t ws_size, hipStream_t stream) {
    static int grid = 0;
    if (grid == 0) {
        if (n_in != 31 || in_sizes[0] != T * D || out_size != T * D || ws_size < WS_END) { fprintf(stderr, "kernel_launch: unexpected shapes (n_in %d, in0 %d, out %d, ws %zu)\n", n_in, n_in > 0 ? in_sizes[0] : -1, out_size, ws_size); grid = -1; return; }
        int dev = 0, cus = 0, per_cu = 0;
        if (hipGetDevice(&dev) != hipSuccess || hipDeviceGetAttribute(&cus, hipDeviceAttributeMultiprocessorCount, dev) != hipSuccess) { grid = -1; return; }
        if (hipFuncSetAttribute((const void*)hymba_fwd, hipFuncAttributeMaxDynamicSharedMemorySize, LDS_BYTES) != hipSuccess) { fprintf(stderr, "kernel_launch: hipFuncSetAttribute failed\n"); grid = -1; return; }
        if (hipOccupancyMaxActiveBlocksPerMultiprocessor(&per_cu, (const void*)hymba_fwd, NTHREADS, LDS_BYTES) != hipSuccess || per_cu < 1) fprintf(stderr, "kernel_launch: occupancy query reports %d workgroups per CU\n", per_cu);
        (void)hipGetLastError();
        grid = cus;
    }
    if (grid < 0) return;
    if (hipMemsetAsync((char*)d_ws + WS_CTL, 0, CTL_ZERO_BYTES, stream) != hipSuccess) return;
    Args a{};
    for (int i = 0; i < 31; ++i) a.in[i] = (const float*)d_in[i];
    a.out = (float*)d_out; a.ws = (unsigned char*)d_ws;
    if (MK_N_LAUNCHES == 1) { a.ph_lo = 0; a.ph_hi = NPH; hipLaunchKernelGGL(hymba_fwd, dim3(grid), dim3(NTHREADS), LDS_BYTES, stream, a); }
    else for (int p = 0; p < NPH; ++p) { a.ph_lo = p; a.ph_hi = p + 1; hipLaunchKernelGGL(hymba_fwd, dim3(grid), dim3(NTHREADS), LDS_BYTES, stream, a); }
}
```
